# Optimizing an MI355X kernel written in HIP

```python
import math
import jax
import jax.numpy as jnp
from jax import lax
import numpy as np

D_MODEL = 2048
BATCH = 8
SEQ = 2048
DEPTH = 2

MLA_HEADS = 8
QK_NOPE = 128
QK_ROPE = 64
V_HEAD = 128
Q_LORA = 512
KV_LORA = 512
ROPE_THETA = 10000.0
Q_BLOCK = 128
GDN_HEADS = 8
GDN_DK = 128
GDN_DV = 128
CONV_WIDTH = 4
CHUNK = 64
GDN_QK = GDN_HEADS * GDN_DK
GDN_V = GDN_HEADS * GDN_DV
CONV_CH = 2 * GDN_QK + GDN_V
D_FF = ((8 * D_MODEL // 3 + 255) // 256) * 256
EPS = 1e-6
IN_SIZES = (Q_LORA, KV_LORA, QK_ROPE, GDN_QK, GDN_QK, GDN_V, GDN_V, GDN_HEADS, GDN_HEADS, 2 * D_MODEL)
IN_WIDTH = Q_LORA + KV_LORA + QK_ROPE + 2 * GDN_QK + 2 * GDN_V + 2 * GDN_HEADS + 2 * D_MODEL

kernel_name = 'hybrid_mla_gdn_adaln_block'


def _rmsnorm(x, w):
    xf = x.astype(jnp.float32)
    y = xf * lax.rsqrt(jnp.mean(xf * xf, axis=-1, keepdims=True) + EPS)
    return (y * w.astype(jnp.float32)).astype(x.dtype)


def _split_cols(p):
    outs, off = [], 0
    for n in IN_SIZES:
        outs.append(p[..., off:off + n])
        off += n
    return outs


def _rope_tables(positions):
    inv_freq = 1.0 / (ROPE_THETA ** (jnp.arange(0, QK_ROPE, 2, dtype=jnp.float32) / QK_ROPE))
    ang = positions.astype(jnp.float32)[..., None] * inv_freq
    return jnp.cos(ang), jnp.sin(ang)


def _rope(x, cos, sin):
    xf = x.astype(jnp.float32)
    x1, x2 = jnp.split(xf, 2, axis=-1)
    return jnp.concatenate([x1 * cos - x2 * sin, x2 * cos + x1 * sin], axis=-1).astype(x.dtype)


def _mla_branch(c_q, c_kv, k_pe, q_norm, kv_norm, w_uq, w_ukv, cos, sin):
    B, T, _ = c_q.shape
    q = (_rmsnorm(c_q, q_norm) @ w_uq).reshape(B, T, MLA_HEADS, QK_NOPE + QK_ROPE)
    q_nope, q_pe = q[..., :QK_NOPE], q[..., QK_NOPE:]
    q_pe = _rope(q_pe, cos[:, :, None, :], sin[:, :, None, :])
    kv = (_rmsnorm(c_kv, kv_norm) @ w_ukv).reshape(B, T, MLA_HEADS, QK_NOPE + V_HEAD)
    k_nope, v = kv[..., :QK_NOPE], kv[..., QK_NOPE:]
    k_pe = _rope(k_pe, cos, sin)
    scale = (QK_NOPE + QK_ROPE) ** -0.5
    outs = []
    for i in range(T // Q_BLOCK):
        q0, k_end = i * Q_BLOCK, (i + 1) * Q_BLOCK
        s = (jnp.einsum('bqhd,bkhd->bhqk', q_nope[:, q0:k_end], k_nope[:, :k_end])
             + jnp.einsum('bqhr,bkr->bhqk', q_pe[:, q0:k_end], k_pe[:, :k_end]))
        s = s.astype(jnp.float32) * scale
        mask = jnp.arange(k_end)[None, :] <= (q0 + jnp.arange(Q_BLOCK))[:, None]
        p = jax.nn.softmax(jnp.where(mask, s, -jnp.inf), axis=-1).astype(v.dtype)
        outs.append(jnp.einsum('bhqk,bkhd->bqhd', p, v[:, :k_end]))
    return jnp.concatenate(outs, axis=1).reshape(B, T, MLA_HEADS * V_HEAD)


def _causal_conv_silu(u, w):
    kern = w[:, None, :].astype(u.dtype)
    y = lax.conv_general_dilated(u, kern, window_strides=(1,), padding=[(CONV_WIDTH - 1, 0)],
                                 dimension_numbers=('NWC', 'WIO', 'NWC'),
                                 feature_group_count=u.shape[-1])
    return jax.nn.silu(y)


def _l2norm(x):
    xf = x.astype(jnp.float32)
    return xf * lax.rsqrt(jnp.sum(xf * xf, axis=-1, keepdims=True) + EPS)


def _gated_delta_chunked(q, k, v, beta, g):
    B, T, H, DK = q.shape
    DV = v.shape[-1]
    N = T // CHUNK
    to_chunks = lambda a: a.reshape(B, N, CHUNK, H, -1).transpose(0, 3, 1, 2, 4)
    q, k, v = to_chunks(q), to_chunks(k), to_chunks(v)
    beta = beta.reshape(B, N, CHUNK, H).transpose(0, 3, 1, 2)
    g = g.reshape(B, N, CHUNK, H).transpose(0, 3, 1, 2)
    G = jnp.cumsum(g, axis=-1)
    idx = jnp.arange(CHUNK)
    lower = idx[:, None] >= idx[None, :]
    strict = idx[:, None] > idx[None, :]
    diff = G[..., :, None] - G[..., None, :]
    decay = jnp.where(lower, jnp.exp(jnp.where(lower, diff, 0.0)), 0.0)
    kb = k * beta[..., None]
    Lmat = jnp.where(strict, jnp.einsum('bhncd,bhnsd->bhncs', kb, k) * decay, 0.0)
    A = Lmat + jnp.eye(CHUNK, dtype=jnp.float32)
    rhs = jnp.concatenate([v * beta[..., None], kb * jnp.exp(G)[..., None]], axis=-1)
    sol = lax.linalg.triangular_solve(A, rhs, left_side=True, lower=True, unit_diagonal=True)
    u, w = sol[..., :DV], sol[..., DV:]
    attn = jnp.where(lower, jnp.einsum('bhncd,bhnsd->bhncs', q, k) * decay, 0.0)

    def step(S, inp):
        q_c, k_c, u_c, w_c, G_c, a_c = inp
        v_new = u_c - jnp.einsum('bhcd,bhde->bhce', w_c, S)
        o = (jnp.einsum('bhcd,bhde->bhce', q_c * jnp.exp(G_c)[..., None], S)
             + jnp.einsum('bhcs,bhse->bhce', a_c, v_new))
        G_last = G_c[..., -1]
        k_dec = k_c * jnp.exp(G_last[..., None] - G_c)[..., None]
        S = S * jnp.exp(G_last)[..., None, None] + jnp.einsum('bhcd,bhce->bhde', k_dec, v_new)
        return S, o

    xs = tuple(jnp.moveaxis(a, 2, 0) for a in (q, k, u, w, G, attn))
    S0 = jnp.zeros((B, H, DK, DV), jnp.float32)
    _, o = lax.scan(step, S0, xs)
    return o.transpose(1, 0, 3, 2, 4).reshape(B, T, H, DV)


def _gdn_branch(qkv, z, b_logit, a_logit, conv_w, A_log, dt_bias, gdn_norm):
    B, T, _ = qkv.shape
    dtype = qkv.dtype
    qkv = _causal_conv_silu(qkv, conv_w)
    q = _l2norm(qkv[..., :GDN_QK].reshape(B, T, GDN_HEADS, GDN_DK)) * (GDN_DK ** -0.5)
    k = _l2norm(qkv[..., GDN_QK:2 * GDN_QK].reshape(B, T, GDN_HEADS, GDN_DK))
    v = qkv[..., 2 * GDN_QK:].reshape(B, T, GDN_HEADS, GDN_DV).astype(jnp.float32)
    beta = jax.nn.sigmoid(b_logit.astype(jnp.float32))
    g = -jnp.exp(A_log.astype(jnp.float32)) * jax.nn.softplus(a_logit.astype(jnp.float32) + dt_bias.astype(jnp.float32))
    o = _gated_delta_chunked(q, k, v, beta, g)
    o = o * lax.rsqrt(jnp.mean(o * o, axis=-1, keepdims=True) + EPS) * gdn_norm.astype(jnp.float32)
    o = o * jax.nn.silu(z.reshape(B, T, GDN_HEADS, GDN_DV).astype(jnp.float32))
    return o.reshape(B, T, GDN_V).astype(dtype)


def setup_inputs(seed: int = 0) -> dict:
    key = jax.random.key(seed)
    ks = jax.random.split(key, 24)
    L, D = DEPTH, D_MODEL
    f32 = jnp.float32

    def nrm(k, shape, fan_in, gain=1.0):
        return gain * fan_in ** -0.5 * jax.random.normal(k, shape, f32)

    def gain(k, shape):
        return 1.0 + 0.02 * jax.random.normal(k, shape, f32)

    x = jax.random.normal(ks[0], (BATCH, SEQ, D), f32)
    c = jax.random.normal(ks[1], (BATCH, D), f32)
    positions = (jnp.arange(SEQ, dtype=jnp.int32)[None, :]
                 + jax.random.randint(ks[2], (BATCH, 1), 0, 1024, dtype=jnp.int32))
    dt = jnp.exp(jax.random.uniform(ks[15], (L, GDN_HEADS), f32, math.log(1e-3), math.log(1e-1)))
    return {
        'x': x,
        'c': c,
        'positions': positions,
        'w_ada': nrm(ks[3], (L, D, 6 * D), D, 0.5),
        'b_ada': 0.01 * jax.random.normal(ks[4], (L, 6 * D), f32),
        'norm_mix': gain(ks[5], (L, D)),
        'norm_ffn': gain(ks[6], (L, D)),
        'w_in': nrm(ks[7], (L, D, IN_WIDTH), D),
        'q_a_norm': gain(ks[8], (L, Q_LORA)),
        'kv_a_norm': gain(ks[9], (L, KV_LORA)),
        'w_uq': nrm(ks[10], (L, Q_LORA, MLA_HEADS * (QK_NOPE + QK_ROPE)), Q_LORA),
        'w_ukv': nrm(ks[11], (L, KV_LORA, MLA_HEADS * (QK_NOPE + V_HEAD)), KV_LORA),
        'w_o_mla': nrm(ks[12], (L, MLA_HEADS * V_HEAD, D), MLA_HEADS * V_HEAD),
        'conv_w': nrm(ks[13], (L, CONV_WIDTH, CONV_CH), CONV_WIDTH),
        'A_log': jnp.log(jax.random.uniform(ks[14], (L, GDN_HEADS), f32, 1.0, 16.0)),
        'dt_bias': dt + jnp.log(-jnp.expm1(-dt)),
        'gdn_norm': gain(ks[16], (L, GDN_DV)),
        'w_o_gdn': nrm(ks[17], (L, GDN_V, D), GDN_V),
        'w_o': nrm(ks[18], (L, D, D), D),
        'w_gate_up': nrm(ks[19], (L, D, 2 * D_FF), D),
        'w_down': nrm(ks[20], (L, D_FF, D), D_FF),
        'final_norm': gain(ks[21], (D,)),
    }


def reference(x, c, positions, w_ada, b_ada, norm_mix, norm_ffn, w_in, q_a_norm, kv_a_norm,
              w_uq, w_ukv, w_o_mla, conv_w, A_log, dt_bias, gdn_norm, w_o_gdn, w_o,
              w_gate_up, w_down, final_norm):
    cos, sin = _rope_tables(positions)
    c_act = jax.nn.silu(c)
    for l in range(DEPTH):
        mod = c_act @ w_ada[l] + b_ada[l]
        sh_a, sc_a, gt_a, sh_f, sc_f, gt_f = [m[:, None, :] for m in jnp.split(mod, 6, axis=-1)]
        h = _rmsnorm(x, norm_mix[l]) * (1.0 + sc_a) + sh_a
        p = h @ w_in[l]
        c_q, c_kv, k_pe, q_g, k_g, v_g, z, b_logit, a_logit, gate_logits = _split_cols(p)
        y_a = _mla_branch(c_q, c_kv, k_pe, q_a_norm[l], kv_a_norm[l], w_uq[l], w_ukv[l], cos, sin) @ w_o_mla[l]
        qkv = jnp.concatenate([q_g, k_g, v_g], axis=-1)
        y_b = _gdn_branch(qkv, z, b_logit, a_logit, conv_w[l], A_log[l], dt_bias[l], gdn_norm[l]) @ w_o_gdn[l]
        g_a, g_b = jnp.split(jax.nn.sigmoid(gate_logits), 2, axis=-1)
        mix = (g_a * y_a + g_b * y_b) @ w_o[l]
        x = x + gt_a * mix
        h = _rmsnorm(x, norm_ffn[l]) * (1.0 + sc_f) + sh_f
        gate, up = jnp.split(h @ w_gate_up[l], 2, axis=-1)
        x = x + gt_f * ((jax.nn.silu(gate) * up) @ w_down[l])
    return _rmsnorm(x, final_norm)
```

```cpp
#include <hip/hip_runtime.h>
#include <hip/hip_cooperative_groups.h>
#include <cstdio>
#include <cstdint>
namespace cg = cooperative_groups;
#define DBG_NO_ATT 0
#define DBG_NO_SCAN 0
#define PROBE_SEL 0

#define LAS __attribute__((address_space(3)))
typedef unsigned short bf16_t;
typedef short bf16x8 __attribute__((ext_vector_type(8)));
typedef short s16x4 __attribute__((ext_vector_type(4)));
typedef float f32x4 __attribute__((ext_vector_type(4)));
typedef float f32x16 __attribute__((ext_vector_type(16)));
typedef unsigned u32x4 __attribute__((ext_vector_type(4)));
typedef unsigned u32x2 __attribute__((ext_vector_type(2)));

constexpr int D = 2048, NB = 8, SEQ = 2048, T = NB * SEQ, DEPTH = 2;
constexpr int NH = 8, DQK = 192, QL = 512;
constexpr int CHK = 64, NCH = SEQ / CHK;
constexpr int DFF = 5632;
constexpr int INW = 9296, INWP = 9472;
constexpr float EPS = 1e-6f;
constexpr int NTHR = 512;
constexpr int LDS_BYTES = 156 * 1024;
constexpr int MISC_OFF = 155 * 1024;

constexpr size_t WS_CTL = 0;
constexpr size_t WS_BAR = 4096;
constexpr size_t WS_MOD = 32768;
constexpr size_t WS_COS = WS_MOD + (size_t)DEPTH * NB * 6 * D * 4;
constexpr size_t WS_SIN = WS_COS + (size_t)T * 32 * 4;
constexpr size_t WS_BA = WS_SIN + (size_t)T * 32 * 4;
constexpr size_t WS_SSQ = WS_BA + (size_t)T * 16 * 4;
constexpr size_t WS_EGL = WS_SSQ + (size_t)T * 16 * 4;
constexpr size_t WS_WIN = WS_EGL + 8192;
constexpr size_t WS_WUQ = WS_WIN + (size_t)INWP * D * 2;
constexpr size_t WS_WUKV = WS_WUQ + (size_t)1536 * 512 * 2;
constexpr size_t WS_WOM = WS_WUKV + (size_t)2048 * 512 * 2;
constexpr size_t WS_WOG = WS_WOM + (size_t)2048 * 1024 * 2;
constexpr size_t WS_WO = WS_WOG + (size_t)2048 * 1024 * 2;
constexpr size_t WS_XA = WS_WO + (size_t)2048 * 2048 * 2;
constexpr size_t WS_H = WS_XA + (size_t)T * D * 4;
constexpr size_t WS_AR = WS_H + (size_t)T * D * 2;
constexpr size_t AR_QKVG = WS_AR;
constexpr size_t AR_CQ = AR_QKVG + (size_t)T * 3072 * 2;
constexpr size_t AR_CKV = AR_CQ + (size_t)T * 512 * 2;
constexpr size_t AR_Z = AR_CKV + (size_t)T * 512 * 2;
constexpr size_t AR_GATE = AR_Z + (size_t)T * 1024 * 2;
constexpr size_t AR_Q = AR_GATE + (size_t)T * 4096 * 2;
constexpr size_t AR_K = AR_Q + (size_t)T * 1536 * 2;
constexpr size_t AR_V = AR_K + (size_t)T * 1536 * 2;
constexpr size_t AR_WG = AR_V + (size_t)T * 1024 * 2;
constexpr size_t AR_QG = AR_WG + (size_t)T * 1024 * 2;
constexpr size_t AR_KDT = AR_QG + (size_t)T * 1024 * 2;
constexpr size_t AR_ATT = AR_KDT + (size_t)T * 1024 * 2;
constexpr size_t AR_END = AR_ATT + (size_t)T * 8 * 64 * 2;
constexpr size_t AR_AO = AR_QKVG;
constexpr size_t AR_GO = AR_AO + (size_t)T * 1024 * 2;
constexpr size_t AR_TMP = AR_Q;
constexpr size_t AR_MIX = AR_WG;
constexpr size_t AR_ACT = WS_AR;
constexpr size_t AR_WGU = AR_ACT + (size_t)T * DFF * 2;
constexpr size_t AR_WDN = AR_WGU + (size_t)11264 * 2048 * 2;
constexpr size_t WS_END = AR_END;
static_assert(AR_WDN + (size_t)2048 * DFF * 2 <= AR_END, "ffn alias overflow");
static_assert(AR_TMP + (size_t)T * D * 4 <= AR_WG, "tmp alias");
static_assert(AR_MIX + (size_t)T * D * 2 <= AR_END, "mix alias");
static_assert(WS_END <= 846000000ull, "workspace");

struct Params {
    const float* x; const float* c; const int* pos; const float* w_ada; const float* b_ada; const float* norm_mix; const float* norm_ffn;
    const float* w_in; const float* q_a_norm; const float* kv_a_norm; const float* w_uq; const float* w_ukv; const float* w_o_mla;
    const float* conv_w; const float* A_log; const float* dt_bias; const float* gdn_norm; const float* w_o_gdn; const float* w_o;
    const float* w_gate_up; const float* w_down; const float* final_norm;
    float* out; unsigned char* ws; int ph_lo, ph_hi;
};

__constant__ float c_inv_freq[32] = {1.000000000e+00f, 7.498942018e-01f, 5.623413324e-01f, 4.216965139e-01f, 3.162277639e-01f, 2.371373773e-01f, 1.778279394e-01f, 1.333521456e-01f,
    1.000000015e-01f, 7.498942316e-02f, 5.623413250e-02f, 4.216964915e-02f, 3.162277490e-02f, 2.371373773e-02f, 1.778279431e-02f, 1.333521400e-02f,
    9.999999776e-03f, 7.498942316e-03f, 5.623413250e-03f, 4.216964822e-03f, 3.162277630e-03f, 2.371373819e-03f, 1.778279431e-03f, 1.333521446e-03f,
    1.000000047e-03f, 7.498941850e-04f, 5.623413017e-04f, 4.216965172e-04f, 3.162277571e-04f, 2.371373703e-04f, 1.778279402e-04f, 1.333521504e-04f};

typedef __bf16 bf16v2_t __attribute__((ext_vector_type(2)));
typedef float f32v2_t __attribute__((ext_vector_type(2)));
__device__ __forceinline__ unsigned cvt_pk_bf16(float lo, float hi) { const bf16v2_t r = __builtin_convertvector((f32v2_t){lo, hi}, bf16v2_t); return __builtin_bit_cast(unsigned, r); }
__device__ __forceinline__ bf16_t f2bf(float f) { unsigned u = __float_as_uint(f); u += 0x7FFFu + ((u >> 16) & 1u); return (bf16_t)(u >> 16); }
__device__ __forceinline__ float bf2f(bf16_t b) { return __uint_as_float(((unsigned)b) << 16); }
__device__ __forceinline__ float bflo(unsigned w) { return __uint_as_float(w << 16); }
__device__ __forceinline__ float bfhi(unsigned w) { return __uint_as_float(w & 0xffff0000u); }
__device__ __forceinline__ u32x4 pack8u(f32x4 a, f32x4 b) { u32x4 w = {cvt_pk_bf16(a[0], a[1]), cvt_pk_bf16(a[2], a[3]), cvt_pk_bf16(b[0], b[1]), cvt_pk_bf16(b[2], b[3])}; return w; }
__device__ __forceinline__ u32x2 pack4u(f32x4 a) { u32x2 w = {cvt_pk_bf16(a[0], a[1]), cvt_pk_bf16(a[2], a[3])}; return w; }
__device__ __forceinline__ float sigmoidf_(float x) { return __builtin_amdgcn_rcpf(1.0f + __expf(-x)); }
__device__ __forceinline__ float siluf_(float x) { return x * __builtin_amdgcn_rcpf(1.0f + __expf(-x)); }
template <int M> __device__ __forceinline__ float swz(float v) { return __int_as_float(__builtin_amdgcn_ds_swizzle(__float_as_int(v), (M << 10) | 0x1F)); }
__device__ __forceinline__ float halfsum(float v) { auto rr = __builtin_amdgcn_permlane32_swap(__float_as_uint(v), __float_as_uint(v), false, false); return __uint_as_float(rr[0]) + __uint_as_float(rr[1]); }
__device__ __forceinline__ float wave_sum(float s) { s += swz<1>(s); s += swz<2>(s); s += swz<4>(s); s += swz<8>(s); s += swz<16>(s); return halfsum(s); }
__device__ __forceinline__ int crow(int r, int hi) { return (r & 3) + 8 * (r >> 2) + 4 * hi; }
__device__ __forceinline__ int ropeperm(int j) { const int g = j >> 3, w = j & 7; return (w < 4) ? (4 * g + w) : (32 + 4 * g + (w - 4)); }

namespace pg8 {
constexpr int BM = 256, BK = 64, HALF = 128, HTB = HALF * BK * 2, STAGE_BYTES = 8 * HTB, NXCD = 8, WGM = 8;
__host__ __device__ __forceinline__ int lds_byte(int r, int c) { const int st = (r >> 4) * 2 + (c >> 5), rr = r & 15, cc = c & 31, ob = rr * 64 + cc * 2; return st * 1024 + (ob ^ (((ob >> 9) & 1) << 5)); }
__host__ __device__ __forceinline__ void stage_rc(int b, int& R, int& C) { const int st = b / 1024, sb = b % 1024, swz = sb ^ (((sb >> 9) & 1) << 5); R = (st >> 1) * 16 + swz / 64; C = (st & 1) * 32 + (swz % 64) / 2; }
__host__ __device__ __forceinline__ int perm32(int rho) { const int n = rho >> 4, i = rho & 15; return 8 * (i >> 2) + 4 * n + (i & 3); }
struct Unit { int pm, pn; };
struct Gemm { const bf16_t* A; const bf16_t* Bt; int M, N, K; };
struct StaticOrder {
    int nM, nN, nwg, G, c;
    __device__ void init(int M, int N, int G_, int c_) { nM = M / BM; nN = N / BM; nwg = nM * nN; G = G_; c = c_; }
    __device__ bool next(int i, Unit& u) const {
        const long L = (long)i * G + c; if (L >= nwg) return false;
        int wgid = (int)L; { const int q = nwg / NXCD, r = nwg % NXCD, xcd = wgid % NXCD, off = wgid / NXCD; wgid = (xcd < r ? xcd * (q + 1) : r * (q + 1) + (xcd - r) * q) + off; }
        const int nig = WGM * nN, gid = wgid / nig, fm = gid * WGM, gsz = (nM - fm) < WGM ? (nM - fm) : WGM;
        u.pm = fm + ((wgid % nig) % gsz); u.pn = (wgid % nig) / gsz; return true;
    }
};
template <class Epi>
__device__ __forceinline__ void gemm_phase(LAS unsigned char* lds, const Gemm g, const Epi& E) {
    int tid = threadIdx.x; asm volatile("" : "+v"(tid));
    int bid = blockIdx.x; asm volatile("" : "+s"(bid));
    StaticOrder S; S.init(g.M, g.N, (int)gridDim.x, bid);
    const int wid = __builtin_amdgcn_readfirstlane(tid >> 6), lane = tid & 63, wr = wid >> 2, wc = wid & 3, fr = lane & 15, fq = lane >> 4;
    const int K = g.K, nt = K / BK;
    unsigned voffA[2], voffB[2];
#pragma unroll
    for (int i = 0; i < 2; ++i) { int R, C; stage_rc(tid * 16 + i * 8192, R, C); const int Rb = Epi::PERM ? ((R & ~31) + perm32(R & 31)) : R;
        voffA[i] = (unsigned)(R * K + C) * 2u; voffB[i] = (unsigned)(Rb * K + C) * 2u; }
    const size_t kstep = (size_t)(BK * 2);
    const size_t hstep = (size_t)HALF * K * 2;
    const size_t tstep = 2 * hstep;
    const unsigned ldsw = (unsigned)wid * 1024u;
    const int aoff = lds_byte(wr * 64 + fr, fq * 8), boff = lds_byte(wc * 32 + fr, fq * 8);
#define PG8_SA(b, h) (((b) * 2 + (h)) * HTB)
#define PG8_SB(b, h) ((4 + (b) * 2 + (h)) * HTB)
#define PG8_STAGE(bufoff, gbase, voff) do { _Pragma("unroll") for (int _i = 0; _i < 2; ++_i) \
        __builtin_amdgcn_global_load_lds((const unsigned*)((const char*)(gbase) + (voff)[_i]), (LAS unsigned*)(lds + (bufoff) + ldsw + _i * 8192), 16, 0, 0); } while (0)
#define PG8_LDA(dst, b, h) do { _Pragma("unroll") for (int m = 0; m < 4; ++m) _Pragma("unroll") for (int k = 0; k < 2; ++k) dst[m][k] = *(const LAS bf16x8*)(lds + PG8_SA(b, h) + aoff + m * 2048 + k * 1024); } while (0)
#define PG8_LDB(dst, b, h) do { _Pragma("unroll") for (int n = 0; n < 2; ++n) _Pragma("unroll") for (int k = 0; k < 2; ++k) dst[n][k] = *(const LAS bf16x8*)(lds + PG8_SB(b, h) + boff + n * 2048 + k * 1024); } while (0)
#define PG8_MMA(ai, bj, At, Bt) do { __builtin_amdgcn_s_setprio(1); _Pragma("unroll") for (int m = 0; m < 4; ++m) _Pragma("unroll") for (int n = 0; n < 2; ++n) _Pragma("unroll") for (int k = 0; k < 2; ++k) \
        acc[ai][bj][m][n] = __builtin_amdgcn_mfma_f32_16x16x32_bf16(Bt[n][k], At[m][k], acc[ai][bj][m][n], 0, 0, 0); __builtin_amdgcn_s_setprio(0); } while (0)
#define PG8_WAIT_V(n) asm volatile("s_waitcnt vmcnt(" #n ")" ::: "memory")
#define PG8_WAIT_L(n) asm volatile("s_waitcnt lgkmcnt(" #n ")" ::: "memory")
#define PG8_BAR __builtin_amdgcn_s_barrier()
#define PG8_SCHED __builtin_amdgcn_sched_barrier(0)
    Unit cur, nxt; int ui = 0;
    if (S.next(0, cur)) {
    f32x4 acc[2][2][4][2];
#pragma unroll
    for (int a = 0; a < 2; ++a)
#pragma unroll
        for (int b = 0; b < 2; ++b)
#pragma unroll
            for (int m = 0; m < 4; ++m)
#pragma unroll
                for (int n = 0; n < 2; ++n) acc[a][b][m][n] = (f32x4){0.f, 0.f, 0.f, 0.f};
    bf16x8 At[4][2], B0[2][2], B1[2][2];
    const char* cA = (const char*)g.A + (size_t)cur.pm * tstep; const char* cB = (const char*)g.Bt + (size_t)cur.pn * tstep;
    PG8_STAGE(PG8_SB(0, 0), cB, voffB); PG8_STAGE(PG8_SA(0, 0), cA, voffA); PG8_STAGE(PG8_SB(0, 1), cB + hstep, voffB); PG8_STAGE(PG8_SA(0, 1), cA + hstep, voffA);
    if (wr == 1) PG8_BAR;
    PG8_WAIT_V(4); PG8_BAR;
    PG8_STAGE(PG8_SB(1, 0), cB + kstep, voffB); PG8_STAGE(PG8_SA(1, 0), cA + kstep, voffA); PG8_STAGE(PG8_SB(1, 1), cB + hstep + kstep, voffB);
    PG8_WAIT_V(6); PG8_BAR;
    for (;;) {
        const bool has_next = S.next(ui + 1, nxt);
        const char* nA = has_next ? (const char*)g.A + (size_t)nxt.pm * tstep : cA; const char* nB = has_next ? (const char*)g.Bt + (size_t)nxt.pn * tstep : cB;
        for (int t = 0; t < nt; t += 2) {
            const bool last = (t == nt - 2);
            const char* a1 = cA + (size_t)(t + 1) * kstep;
            const char* a2 = last ? nA : cA + (size_t)(t + 2) * kstep; const char* b2 = last ? nB : cB + (size_t)(t + 2) * kstep;
            const char* a3 = a2 + kstep; const char* b3 = b2 + kstep;
            PG8_LDB(B0, 0, 0); PG8_SCHED; PG8_LDA(At, 0, 0); PG8_STAGE(PG8_SA(1, 1), a1 + hstep, voffA);
            PG8_WAIT_L(8); PG8_BAR; PG8_WAIT_L(0); PG8_MMA(0, 0, At, B0); PG8_BAR; PG8_SCHED;
            PG8_LDB(B1, 0, 1); PG8_STAGE(PG8_SB(0, 0), b2, voffB);
            PG8_BAR; PG8_WAIT_L(0); PG8_MMA(0, 1, At, B1); PG8_BAR;
            PG8_LDA(At, 0, 1); PG8_STAGE(PG8_SA(0, 0), a2, voffA);
            PG8_BAR; PG8_WAIT_L(0); PG8_MMA(1, 0, At, B0); PG8_BAR; PG8_SCHED;
            PG8_STAGE(PG8_SB(0, 1), b2 + hstep, voffB);
            PG8_WAIT_V(6); PG8_BAR; PG8_MMA(1, 1, At, B1); PG8_BAR;
            PG8_LDB(B0, 1, 0); PG8_SCHED; PG8_LDA(At, 1, 0); PG8_STAGE(PG8_SA(0, 1), a2 + hstep, voffA);
            PG8_WAIT_L(8); PG8_BAR; PG8_WAIT_L(0); PG8_MMA(0, 0, At, B0); PG8_BAR; PG8_SCHED;
            PG8_LDB(B1, 1, 1); PG8_STAGE(PG8_SB(1, 0), b3, voffB);
            PG8_BAR; PG8_WAIT_L(0); PG8_MMA(0, 1, At, B1); PG8_BAR;
            PG8_LDA(At, 1, 1); PG8_STAGE(PG8_SA(1, 0), a3, voffA);
            PG8_BAR; PG8_WAIT_L(0); PG8_MMA(1, 0, At, B0); PG8_BAR; PG8_SCHED;
            PG8_STAGE(PG8_SB(1, 1), b3 + hstep, voffB);
            PG8_WAIT_V(6); PG8_BAR; PG8_MMA(1, 1, At, B1); PG8_BAR;
        }
        E(acc, cur, wr, wc, fr, fq);
        if (!has_next) break;
#pragma unroll
        for (int a = 0; a < 2; ++a)
#pragma unroll
            for (int b = 0; b < 2; ++b)
#pragma unroll
                for (int m = 0; m < 4; ++m)
#pragma unroll
                    for (int n = 0; n < 2; ++n) acc[a][b][m][n] = (f32x4){0.f, 0.f, 0.f, 0.f};
        cur = nxt; cA = nA; cB = nB; ++ui;
    }
    PG8_WAIT_V(0);
    if (wr == 0) PG8_BAR;
    PG8_BAR;
    }
    __syncthreads();
#undef PG8_SA
#undef PG8_SB
#undef PG8_STAGE
#undef PG8_LDA
#undef PG8_LDB
#undef PG8_MMA
#undef PG8_WAIT_V
#undef PG8_WAIT_L
#undef PG8_BAR
#undef PG8_SCHED
}
}
using pg8::Unit;
typedef f32x4 AccT[2][2][4][2];

struct EpiIn {
    static constexpr bool PERM = true;
    bf16_t* CQ; bf16_t* CKV; bf16_t* QKVG; bf16_t* Z; bf16_t* GATE; bf16_t* Kb; float* SSQ; float* BA; const float* COS; const float* SIN;
    __device__ __forceinline__ void operator()(const AccT& acc, const Unit& u, int wr, int wc, int fr, int fq) const {
        const int pn = u.pn;
        if (pn < 36) {
            bf16_t* base; int ld;
            if (pn < 4) { base = (pn < 2 ? CQ : CKV) + (pn & 1) * 256; ld = 512; }
            else if (pn < 16) { base = QKVG + (pn - 4) * 256; ld = 3072; }
            else if (pn < 20) { base = Z + (pn - 16) * 256; ld = 1024; }
            else { base = GATE + (pn - 20) * 256; ld = 4096; }
            base += wc * 32 + fq * 8;
#pragma unroll
            for (int ai = 0; ai < 2; ++ai)
#pragma unroll
                for (int m = 0; m < 4; ++m) {
                    const int row = u.pm * 256 + ai * 128 + wr * 64 + m * 16 + fr;
                    bf16_t* dst = base + (size_t)row * ld; float s = 0.f;
#pragma unroll
                    for (int bj = 0; bj < 2; ++bj) { f32x4 v0 = acc[ai][bj][m][0], v1 = acc[ai][bj][m][1];
                        if (pn < 4) s += (v0[0] * v0[0] + v0[1] * v0[1]) + (v0[2] * v0[2] + v0[3] * v0[3]) + (v1[0] * v1[0] + v1[1] * v1[1]) + (v1[2] * v1[2] + v1[3] * v1[3]);
                        if (pn >= 20) {
#pragma unroll
                            for (int j = 0; j < 4; ++j) { v0[j] = sigmoidf_(v0[j]); v1[j] = sigmoidf_(v1[j]); } }
                        *(u32x4*)(dst + bj * 128) = pack8u(v0, v1); }
                    if (pn < 4) { s += swz<16>(s); s = halfsum(s); if (fq == 0) SSQ[(size_t)row * 16 + pn * 4 + wc] = s; }
                }
        } else {
            const int g8 = wc * 4 + fq;
#pragma unroll
            for (int ai = 0; ai < 2; ++ai)
#pragma unroll
                for (int m = 0; m < 4; ++m) {
                    const int row = u.pm * 256 + ai * 128 + wr * 64 + m * 16 + fr;
                    const f32x4 v0 = acc[ai][0][m][0], v1 = acc[ai][0][m][1];
                    if (g8 < 8) {
                        const int i0 = 4 * g8;
                        const f32x4 cs = *(const f32x4*)(COS + (size_t)row * 32 + i0), sn = *(const f32x4*)(SIN + (size_t)row * 32 + i0);
                        const f32x4 o1 = v0 * cs - v1 * sn, o2 = v1 * cs + v0 * sn;
                        const u32x2 w1 = pack4u(o1), w2 = pack4u(o2);
                        const int b = row / SEQ, t = row % SEQ;
                        bf16_t* kp = Kb + ((size_t)(b * NH) * SEQ + t) * DQK + 128 + i0;
#pragma unroll
                        for (int h = 0; h < NH; ++h) { *(u32x2*)(kp + (size_t)h * SEQ * DQK) = w1; *(u32x2*)(kp + (size_t)h * SEQ * DQK + 32) = w2; }
                    } else if (g8 < 10) { float* bp = BA + (size_t)row * 16 + (g8 - 8) * 8; *(f32x4*)bp = v0; *(f32x4*)(bp + 4) = v1; }
                }
        }
    }
};
struct EpiQKV {
    static constexpr bool PERM = true;
    bf16_t* Q; bf16_t* Kb; bf16_t* Vb; const float* SSQ; const float* COS; const float* SIN; int mode;
    __device__ __forceinline__ void operator()(const AccT& acc, const Unit& u, int wr, int wc, int fr, int fq) const {
#pragma unroll
        for (int ai = 0; ai < 2; ++ai)
#pragma unroll
            for (int m = 0; m < 4; ++m) {
                const int row = u.pm * 256 + ai * 128 + wr * 64 + m * 16 + fr; const int b = row / SEQ, t = row % SEQ;
                const f32x4 s0 = *(const f32x4*)(SSQ + (size_t)row * 16 + mode * 8), s1 = *(const f32x4*)(SSQ + (size_t)row * 16 + mode * 8 + 4);
                const float ssq = (s0[0] + s0[1]) + (s0[2] + s0[3]) + (s1[0] + s1[1]) + (s1[2] + s1[3]);
                float rs = rsqrtf(ssq * (1.0f / 512.0f) + EPS);
                if (mode == 0) {
                    rs *= (0.07216878364870322f * 1.4426950408889634f);
#pragma unroll
                    for (int bj = 0; bj < 2; ++bj) {
                        const int c8 = u.pn * 256 + bj * 128 + wc * 32 + fq * 8; const int head = c8 / DQK, d0 = c8 % DQK;
                        bf16_t* qp = Q + ((size_t)(b * NH + head) * SEQ + t) * DQK;
                        const f32x4 v0 = acc[ai][bj][m][0] * rs, v1 = acc[ai][bj][m][1] * rs;
                        if (d0 < 128) { *(u32x4*)(qp + d0) = pack8u(v0, v1); }
                        else { const int i0 = 4 * ((d0 - 128) >> 3);
                            const f32x4 cs = *(const f32x4*)(COS + (size_t)row * 32 + i0), sn = *(const f32x4*)(SIN + (size_t)row * 32 + i0);
                            const f32x4 o1 = v0 * cs - v1 * sn, o2 = v1 * cs + v0 * sn;
                            *(u32x2*)(qp + 128 + i0) = pack4u(o1); *(u32x2*)(qp + 160 + i0) = pack4u(o2); }
                    }
                } else {
                    const size_t bh = (size_t)(b * NH + u.pn) * SEQ + t; const int d = wc * 32 + fq * 8;
                    *(u32x4*)(Kb + bh * DQK + d) = pack8u(acc[ai][0][m][0] * rs, acc[ai][0][m][1] * rs);
                    *(u32x4*)(Vb + bh * 128 + d) = pack8u(acc[ai][1][m][0] * rs, acc[ai][1][m][1] * rs);
                }
            }
    }
};
struct EpiOut {
    static constexpr bool PERM = true;
    const bf16_t* GATE; float* TMP; bf16_t* MIX; int SECOND;
    __device__ __forceinline__ void operator()(const AccT& acc, const Unit& u, int wr, int wc, int fr, int fq) const {
#pragma unroll
        for (int ai = 0; ai < 2; ++ai)
#pragma unroll
            for (int m = 0; m < 4; ++m) {
                const int row = u.pm * 256 + ai * 128 + wr * 64 + m * 16 + fr;
#pragma unroll
                for (int bj = 0; bj < 2; ++bj) {
                    const int c8 = u.pn * 256 + bj * 128 + wc * 32 + fq * 8;
                    const u32x4 gw = *(const u32x4*)(GATE + (size_t)row * 4096 + SECOND * 2048 + c8);
                    const f32x4 g0 = {bflo(gw[0]), bfhi(gw[0]), bflo(gw[1]), bfhi(gw[1])}, g1 = {bflo(gw[2]), bfhi(gw[2]), bflo(gw[3]), bfhi(gw[3])};
                    bf16_t* tp = (bf16_t*)TMP + (size_t)row * 2048 + c8;
                    if (SECOND == 0) { *(u32x4*)tp = pack8u(g0 * acc[ai][bj][m][0], g1 * acc[ai][bj][m][1]); }
                    else { const u32x4 tw = *(const u32x4*)tp;
                        const f32x4 t0 = {bflo(tw[0]), bfhi(tw[0]), bflo(tw[1]), bfhi(tw[1])}, t1 = {bflo(tw[2]), bfhi(tw[2]), bflo(tw[3]), bfhi(tw[3])};
                        const f32x4 a0 = t0 + g0 * acc[ai][bj][m][0], a1 = t1 + g1 * acc[ai][bj][m][1];
                        *(u32x4*)(MIX + (size_t)row * 2048 + c8) = pack8u(a0, a1); }
                }
            }
    }
};
struct EpiResid {
    static constexpr bool PERM = true;
    const float* XINF; const bf16_t* XIN16; bf16_t* XOUT; const float* GT;
    __device__ __forceinline__ void operator()(const AccT& acc, const Unit& u, int wr, int wc, int fr, int fq) const {
        const int b = (u.pm * 256) / SEQ;
        f32x4 gt[2][2];
#pragma unroll
        for (int bj = 0; bj < 2; ++bj)
#pragma unroll
            for (int n = 0; n < 2; ++n) gt[bj][n] = *(const f32x4*)(GT + (size_t)b * 6 * D + u.pn * 256 + bj * 128 + wc * 32 + fq * 8 + 4 * n);
#pragma unroll
        for (int ai = 0; ai < 2; ++ai)
#pragma unroll
            for (int m = 0; m < 4; ++m) {
                const int row = u.pm * 256 + ai * 128 + wr * 64 + m * 16 + fr;
#pragma unroll
                for (int bj = 0; bj < 2; ++bj) {
                    const size_t off = (size_t)row * D + u.pn * 256 + bj * 128 + wc * 32 + fq * 8;
                    f32x4 x0, x1;
                    if (XINF) { x0 = *(const f32x4*)(XINF + off); x1 = *(const f32x4*)(XINF + off + 4); }
                    else { const u32x4 w = *(const u32x4*)(XIN16 + off); x0 = (f32x4){bflo(w[0]), bfhi(w[0]), bflo(w[1]), bfhi(w[1])}; x1 = (f32x4){bflo(w[2]), bfhi(w[2]), bflo(w[3]), bfhi(w[3])}; }
                    *(u32x4*)(XOUT + off) = pack8u(x0 + gt[bj][0] * acc[ai][bj][m][0], x1 + gt[bj][1] * acc[ai][bj][m][1]);
                }
            }
    }
};
struct EpiSwiGLU {
    static constexpr bool PERM = true;
    bf16_t* ACT;
    __device__ __forceinline__ void operator()(const AccT& acc, const Unit& u, int wr, int wc, int fr, int fq) const {
#pragma unroll
        for (int ai = 0; ai < 2; ++ai)
#pragma unroll
            for (int m = 0; m < 4; ++m) {
                const int row = u.pm * 256 + ai * 128 + wr * 64 + m * 16 + fr;
                f32x4 o0, o1;
#pragma unroll
                for (int j = 0; j < 4; ++j) { o0[j] = siluf_(acc[ai][0][m][0][j]) * acc[ai][1][m][0][j]; o1[j] = siluf_(acc[ai][0][m][1][j]) * acc[ai][1][m][1][j]; }
                *(u32x4*)(ACT + (size_t)row * DFF + u.pn * 128 + wc * 32 + fq * 8) = pack8u(o0, o1);
            }
    }
};

enum { WT_IN = 0, WT_UQ, WT_UKV, WT_NAT, WT_GU };
__device__ __forceinline__ int wsrc_col(int type, int n) {
    switch (type) {
    case WT_IN: { const int pn = n >> 8, j = n & 255;
        if (pn < 4) return n;
        if (pn < 20) return 1088 + (n - 1024);
        if (pn < 36) return 5200 + (n - 5120);
        if (j < 64) return 1024 + ropeperm(j);
        if (j < 72) return 5184 + (j - 64);
        if (j < 80) return 5192 + (j - 72);
        return -1; }
    case WT_UQ: { const int h = n / DQK, d = n % DQK; return d < 128 ? n : h * DQK + 128 + ropeperm(d - 128); }
    case WT_GU: { const int pn = n >> 8, j = n & 255; return (j >> 7) * DFF + pn * 128 + (j & 127); }
    default: return n;
    }
}
__device__ __forceinline__ void conv_tile(LAS unsigned char* lds, const float* __restrict__ src, int Nsrc, bf16_t* __restrict__ dst, int K, int type, const float* __restrict__ ksc, int kt, int nt) {
    LAS bf16_t* tile = (LAS bf16_t*)lds;
    int tid = threadIdx.x; asm volatile("" : "+v"(tid));
    const int n4 = (tid & 63) * 4, kr = tid >> 6;
    const int sc = wsrc_col(type, nt * 256 + n4);
    f32x4 v[8];
#pragma unroll
    for (int i = 0; i < 8; ++i) { const int k = kt * 64 + kr + 8 * i; v[i] = (f32x4){0.f, 0.f, 0.f, 0.f};
        if (sc >= 0) { v[i] = *(const f32x4*)(src + (size_t)k * Nsrc + sc); if (ksc) v[i] *= ksc[k]; } }
#pragma unroll
    for (int i = 0; i < 8; ++i) {
#pragma unroll
        for (int j = 0; j < 4; ++j) tile[(n4 + j) * 72 + kr + 8 * i] = f2bf(v[i][j]); }
    __syncthreads();
#pragma unroll
    for (int e = 0; e < 4; ++e) { const int id = tid + e * NTHR, n2 = id >> 3, kc = id & 7;
        const u32x4 w = *(const LAS u32x4*)(tile + n2 * 72 + kc * 8);
        *(u32x4*)(dst + (size_t)(nt * 256 + n2) * K + kt * 64 + kc * 8) = w; }
    __syncthreads();
}
struct WDesc { const float* src; bf16_t* dst; const float* ksc; int K, Nsrc, Ndst, type; };
__device__ __forceinline__ void conv_item(LAS unsigned char* lds, const WDesc& w, int it) { const int nkt = w.K / 64; conv_tile(lds, w.src, w.Nsrc, w.dst, w.K, w.type, w.ksc, it % nkt, it / nkt); }
__device__ __forceinline__ int wtiles(const WDesc& w) { return (w.K / 64) * (w.Ndst / 256); }

__device__ __forceinline__ void ada_item(LAS unsigned char* lds, const Params& p, int item) {
    LAS float* sc = (LAS float*)lds;
    LAS float* red = (LAS float*)(lds + 65536);
    int tid = threadIdx.x; asm volatile("" : "+v"(tid));
    const int l = item / 96, col0 = (item % 96) * 128, cg4 = (tid & 31) * 4, ks = tid >> 5;
    for (int i = tid; i < NB * D; i += NTHR) sc[i] = siluf_(p.c[i]);
    __syncthreads();
    float acc[8][4];
#pragma unroll
    for (int b = 0; b < 8; ++b)
#pragma unroll
        for (int j = 0; j < 4; ++j) acc[b][j] = 0.f;
    const float* wp = p.w_ada + (size_t)l * D * 6 * D + (size_t)(ks * 128) * 6 * D + col0 + cg4;
#pragma unroll 16
    for (int k = 0; k < 128; ++k) { const f32x4 w = *(const f32x4*)(wp + (size_t)k * 6 * D);
#pragma unroll
        for (int b = 0; b < 8; ++b) { const float s = sc[b * D + ks * 128 + k];
#pragma unroll
            for (int j = 0; j < 4; ++j) acc[b][j] += s * w[j]; } }
#pragma unroll
    for (int b = 0; b < 8; ++b) *(LAS f32x4*)(red + (ks * 8 + b) * 128 + cg4) = (f32x4){acc[b][0], acc[b][1], acc[b][2], acc[b][3]};
    __syncthreads();
    for (int o = tid; o < 8 * 128; o += NTHR) { const int b = o >> 7, cc = o & 127; float s = 0.f;
#pragma unroll
        for (int k2 = 0; k2 < 16; ++k2) s += red[(k2 * 8 + b) * 128 + cc];
        float* mod = (float*)(p.ws + WS_MOD);
        mod[((size_t)l * NB + b) * 6 * D + col0 + cc] = s + p.b_ada[(size_t)l * 6 * D + col0 + cc]; }
    __syncthreads();
}
__device__ __forceinline__ void rope_item(const Params& p, int item) {
    float* COS = (float*)(p.ws + WS_COS); float* SIN = (float*)(p.ws + WS_SIN);
    int tid = threadIdx.x; asm volatile("" : "+v"(tid));
#pragma unroll
    for (int e = 0; e < 8; ++e) { const int idx = item * 4096 + e * NTHR + tid; const int t = idx >> 5, i = idx & 31;
        const float ang = (float)p.pos[t] * c_inv_freq[i];
        const double a = (double)ang; const double k = rint(a * 0.15915494309189535); const float r = (float)(a - k * 6.283185307179586);
        COS[idx] = __cosf(r); SIN[idx] = __sinf(r); }
}

template <bool FINAL, bool SRC16 = false>
__device__ __forceinline__ void norm_rows(const float* __restrict__ xin, const bf16_t* __restrict__ xin16, const float* __restrict__ w, const float* __restrict__ modl, int sh_k, int sc_k, bf16_t* __restrict__ dst, float* __restrict__ fout) {
    int tid = threadIdx.x; asm volatile("" : "+v"(tid));
    const int lane = tid & 63, gw = blockIdx.x * 8 + (tid >> 6), nw = gridDim.x * 8;
    for (int row = gw; row < T; row += nw) {
        const int b = row / SEQ;
        if (SRC16) {
            f32x4 v[4][2]; float s = 0.f;
#pragma unroll
            for (int i = 0; i < 4; ++i) { const u32x4 r4 = *(const u32x4*)(xin16 + (size_t)row * D + (i * 64 + lane) * 8);
                v[i][0] = (f32x4){bflo(r4[0]), bfhi(r4[0]), bflo(r4[1]), bfhi(r4[1])}; v[i][1] = (f32x4){bflo(r4[2]), bfhi(r4[2]), bflo(r4[3]), bfhi(r4[3])};
#pragma unroll
                for (int hh = 0; hh < 2; ++hh) s += (v[i][hh][0] * v[i][hh][0] + v[i][hh][1] * v[i][hh][1]) + (v[i][hh][2] * v[i][hh][2] + v[i][hh][3] * v[i][hh][3]); }
            s = wave_sum(s);
            const float rs = rsqrtf(s * (1.0f / D) + EPS);
#pragma unroll
            for (int i = 0; i < 4; ++i) { const int c = (i * 64 + lane) * 8; f32x4 o[2];
#pragma unroll
                for (int hh = 0; hh < 2; ++hh) { const f32x4 ww = *(const f32x4*)(w + c + 4 * hh);
                    if (FINAL) o[hh] = v[i][hh] * rs * ww;
                    else { const f32x4 sh = *(const f32x4*)(modl + (size_t)b * 6 * D + sh_k * D + c + 4 * hh), sc = *(const f32x4*)(modl + (size_t)b * 6 * D + sc_k * D + c + 4 * hh);
                        o[hh] = v[i][hh] * rs * ww * (sc + 1.0f) + sh; } }
                if (FINAL) { *(f32x4*)(fout + (size_t)row * D + c) = o[0]; *(f32x4*)(fout + (size_t)row * D + c + 4) = o[1]; }
                else *(u32x4*)(dst + (size_t)row * D + c) = pack8u(o[0], o[1]); }
        } else {
            f32x4 v[8]; float s = 0.f;
#pragma unroll
            for (int i = 0; i < 8; ++i) { v[i] = *(const f32x4*)(xin + (size_t)row * D + (i * 64 + lane) * 4);
                s += (v[i][0] * v[i][0] + v[i][1] * v[i][1]) + (v[i][2] * v[i][2] + v[i][3] * v[i][3]); }
            s = wave_sum(s);
            const float rs = rsqrtf(s * (1.0f / D) + EPS);
#pragma unroll
            for (int i = 0; i < 8; ++i) { const int c = (i * 64 + lane) * 4; const f32x4 ww = *(const f32x4*)(w + c);
                if (FINAL) { *(f32x4*)(fout + (size_t)row * D + c) = v[i] * rs * ww; }
                else { const f32x4 sh = *(const f32x4*)(modl + (size_t)b * 6 * D + sh_k * D + c), sc = *(const f32x4*)(modl + (size_t)b * 6 * D + sc_k * D + c);
                    const f32x4 o = v[i] * rs * ww * (sc + 1.0f) + sh; *(u32x2*)(dst + (size_t)row * D + c) = pack4u(o); } }
        }
    }
}
#define LDS_BAR() do { asm volatile("s_waitcnt lgkmcnt(0)" ::: "memory"); __builtin_amdgcn_s_barrier(); asm volatile("" ::: "memory"); } while (0)
namespace att {
constexpr int KVBLK = 64, QB = 256, SHM_V = KVBLK * 128 * 2, SHM_K = KVBLK * DQK * 2;
constexpr int OFF_V = 0, OFF_K = 3 * SHM_V, OFF_W = OFF_K + 3 * SHM_K;
static_assert(OFF_W + 2048 <= MISC_OFF, "attention LDS");
__device__ __forceinline__ int v_st(int k, int c) { const int kk = (k & ~0xC) | ((k & 4) << 1) | ((k & 8) >> 1); return ((kk >> 3) * 4 + (c >> 5)) * 512 + ((kk & 7) * 32 + (c & 31)) * 2; }
__device__ __forceinline__ int v_rd_base(int lane) { return ((lane & 3) << 3) | (((lane >> 2) & 3) << 6) | (((lane >> 4) & 1) << 5) | (((lane >> 5) & 1) << 8); }
constexpr int v_rd_off(int d0, int ks, int half) { return d0 * 512 + ks * 4096 + half * 2048; }
#define ATT_SBAR() __builtin_amdgcn_sched_barrier(0)
constexpr float THR = 8.f;
__device__ __forceinline__ void partialSM(f32x16& p0, f32x16& p1, float& m_reg, float& alpha) {
    float pmax = p0[0];
#pragma unroll
    for (int r = 1; r < 16; ++r) pmax = fmaxf(pmax, p0[r]);
#pragma unroll
    for (int r = 0; r < 16; ++r) pmax = fmaxf(pmax, p1[r]);
    { auto rr = __builtin_amdgcn_permlane32_swap(__float_as_uint(pmax), __float_as_uint(pmax), false, false);
      pmax = fmaxf(__uint_as_float(rr[0]), __uint_as_float(rr[1])); }
    float mn;
    if (__all((pmax - m_reg) <= THR)) { mn = m_reg; alpha = 1.f; }
    else { mn = fmaxf(m_reg, pmax); alpha = __builtin_amdgcn_exp2f(m_reg - mn); m_reg = mn; }
#pragma unroll
    for (int r = 0; r < 16; ++r) { p0[r] = __builtin_amdgcn_exp2f(p0[r] - mn); p1[r] = __builtin_amdgcn_exp2f(p1[r] - mn); }
}
__device__ __forceinline__ void finishSM(const f32x16& p0, const f32x16& p1, float alpha, float& l_reg, bf16x8& pa0, bf16x8& pa1, bf16x8& pa2, bf16x8& pa3) {
    float ps = 0;
#pragma unroll
    for (int r = 0; r < 16; ++r) ps += p0[r];
#pragma unroll
    for (int r = 0; r < 16; ++r) ps += p1[r];
    { auto rr = __builtin_amdgcn_permlane32_swap(__float_as_uint(ps), __float_as_uint(ps), false, false);
      ps = __uint_as_float(rr[0]) + __uint_as_float(rr[1]); }
    l_reg = l_reg * alpha + ps;
#define PK4(P, B_, OUT) do { unsigned a0 = cvt_pk_bf16(P[B_+0], P[B_+1]), a1 = cvt_pk_bf16(P[B_+2], P[B_+3]);                          \
        unsigned b0 = cvt_pk_bf16(P[B_+4], P[B_+5]), b1 = cvt_pk_bf16(P[B_+6], P[B_+7]);                                             \
        auto r0 = __builtin_amdgcn_permlane32_swap(a0, b0, false, false); auto r1 = __builtin_amdgcn_permlane32_swap(a1, b1, false, false); \
        u32x4 w = {r0[0], r1[0], r0[1], r1[1]}; OUT = *reinterpret_cast<bf16x8*>(&w); } while (0)
    PK4(p0, 0, pa0); PK4(p0, 8, pa1); PK4(p1, 0, pa2); PK4(p1, 8, pa3);
#undef PK4
}
template <int KB>
__device__ __forceinline__ void qkt(f32x16& p0, f32x16& p1, const LAS char* K_lds, int r32, int hi, const bf16x8* qr) {
    p0 = f32x16{}; p1 = f32x16{};
    const LAS char* kb[4];
#pragma unroll
    for (int dd = 0; dd < 4; ++dd) kb[dd] = K_lds + KB * SHM_K + r32 * 384 + (((2 * dd + hi) ^ (r32 & 7)) << 4);
#pragma unroll
    for (int d0 = 0; d0 < 12; ++d0) { const LAS char* a = kb[d0 & 3] + (d0 >> 2) * 128;
        bf16x8 b0 = *(const LAS bf16x8*)(a);
        bf16x8 b1 = *(const LAS bf16x8*)(a + 32 * 384);
        p0 = __builtin_amdgcn_mfma_f32_32x32x16_bf16(b0, qr[d0], p0, 0, 0, 0);
        p1 = __builtin_amdgcn_mfma_f32_32x32x16_bf16(b1, qr[d0], p1, 0, 0, 0); }
}
template <int VB>
__device__ __forceinline__ void pv_tile(f32x16* o, int vb0, bf16x8 pa0, bf16x8 pa1, bf16x8 pa2, bf16x8 pa3) {
#define TRRD(dst, off) asm volatile("ds_read_b64_tr_b16 %0, %1 offset:%2" : "=&v"(dst) : "v"(vb0), "i"(off) : "memory")
#define PV_D0(d0) do { s16x4 l0, l1, l2, l3, h0, h1, h2, h3; constexpr int b_ = VB * SHM_V + v_rd_off(d0, 0, 0); \
        TRRD(l0, b_); TRRD(h0, b_ + 2048); TRRD(l1, b_ + 4096); TRRD(h1, b_ + 6144); TRRD(l2, b_ + 8192); TRRD(h2, b_ + 10240); TRRD(l3, b_ + 12288); TRRD(h3, b_ + 14336); \
        asm volatile("s_waitcnt lgkmcnt(0)" ::: "memory"); ATT_SBAR();   \
        o[d0] = __builtin_amdgcn_mfma_f32_32x32x16_bf16(pa0, (bf16x8){l0[0], l0[1], l0[2], l0[3], h0[0], h0[1], h0[2], h0[3]}, o[d0], 0, 0, 0);   \
        o[d0] = __builtin_amdgcn_mfma_f32_32x32x16_bf16(pa1, (bf16x8){l1[0], l1[1], l1[2], l1[3], h1[0], h1[1], h1[2], h1[3]}, o[d0], 0, 0, 0);   \
        o[d0] = __builtin_amdgcn_mfma_f32_32x32x16_bf16(pa2, (bf16x8){l2[0], l2[1], l2[2], l2[3], h2[0], h2[1], h2[2], h2[3]}, o[d0], 0, 0, 0);   \
        o[d0] = __builtin_amdgcn_mfma_f32_32x32x16_bf16(pa3, (bf16x8){l3[0], l3[1], l3[2], l3[3], h3[0], h3[1], h3[2], h3[3]}, o[d0], 0, 0, 0); } while (0)
    PV_D0(0); PV_D0(1); PV_D0(2); PV_D0(3);
#undef PV_D0
#undef TRRD
}
__device__ __forceinline__ void attn_unit(LAS unsigned char* lds, const bf16_t* __restrict__ Q, const bf16_t* __restrict__ Kg, const bf16_t* __restrict__ Vg, bf16_t* __restrict__ AO, int b, int h, int qb) {
    int tid = threadIdx.x; asm volatile("" : "+v"(tid));
    const int wid = __builtin_amdgcn_readfirstlane(tid >> 6), lane = tid & 63, r32 = lane & 31, hi = lane >> 5;
    const int P0 = qb * QB, NT = 4 * (qb + 1), qlo = P0 + wid * 32;
    const bf16_t* Qp = Q + (size_t)(b * NH + h) * SEQ * DQK; const bf16_t* Kp = Kg + (size_t)(b * NH + h) * SEQ * DQK; const bf16_t* Vp = Vg + (size_t)(b * NH + h) * SEQ * 128;
    const LAS char* K_lds = (const LAS char*)lds + OFF_K;
    LAS float* ws = (LAS float*)(lds + OFF_W) + wid * 64; LAS float* li_l = ws; LAS float* al_l = ws + 32;
    bf16x8 qr[12];
#pragma unroll
    for (int d0 = 0; d0 < 12; ++d0) qr[d0] = *(const bf16x8*)(Qp + (size_t)(qlo + r32) * DQK + d0 * 16 + hi * 8);
    int vso0;
    { const int o = tid * 16, sub = o >> 9, rem = (o & 511) >> 1; const int kk = (sub >> 2) * 8 + (rem >> 5), c = (sub & 3) * 32 + (rem & 31);
      const int k = (kk & ~0xC) | ((kk & 4) << 1) | ((kk & 8) >> 1); vso0 = k * 128 + c; }
#define ATT_LOAD(t_, bf_) do { const bf16_t* kk_ = Kp + (size_t)(t_) * KVBLK * DQK; const bf16_t* vv_ = Vp + (size_t)(t_) * KVBLK * 128; int tt_ = tid; asm volatile("" : "+v"(tt_)); \
        _Pragma("unroll") for (int i = 0; i < 3; ++i) { const int id = tt_ + i * NTHR, row = id / 24, cc = id % 24; \
            __builtin_amdgcn_global_load_lds((const unsigned*)(kk_ + row * DQK + ((cc ^ (row & 7)) << 3)), (LAS unsigned*)(lds + OFF_K + (bf_) * SHM_K + (i * NTHR + wid * 64) * 16), 16, 0, 0); } \
        _Pragma("unroll") for (int i = 0; i < 2; ++i) __builtin_amdgcn_global_load_lds((const unsigned*)(vv_ + vso0 + i * 32 * 128), (LAS unsigned*)(lds + OFF_V + (bf_) * SHM_V + (i * NTHR + wid * 64) * 16), 16, 0, 0); } while (0)
    ATT_LOAD(0, 0);
    if (NT > 1) { ATT_LOAD(1, 1); asm volatile("s_waitcnt vmcnt(5)" ::: "memory"); } else { asm volatile("s_waitcnt vmcnt(0)" ::: "memory"); }
    LDS_BAR();
    float m_reg = -1e30f, l_reg = 0.f; f32x16 o[4] = {};
    const int vb0 = (int)(unsigned)(uintptr_t)(lds + OFF_V) + v_rd_base(lane);
#define ATT_STEP(BI) do { \
        if (kb <= qlo + 31) {                                                 \
            f32x16 p0, p1; float alpha; bf16x8 pa0, pa1, pa2, pa3; \
            qkt<BI>(p0, p1, K_lds, r32, hi, qr); \
            if (kb + KVBLK - 1 > qlo) {                                       \
                const int dq = qlo + r32 - kb - 4 * hi; const float NEG = -__builtin_inff(); \
                _Pragma("unroll") for (int r = 0; r < 16; ++r) { const int c = (r & 3) + 8 * (r >> 2); if (dq - c < 0) p0[r] = NEG; if (dq - c - 32 < 0) p1[r] = NEG; } \
            } \
            partialSM(p0, p1, m_reg, alpha); \
            if (__any(alpha < 1.f)) { if (hi == 0) al_l[r32] = alpha; asm volatile("s_waitcnt lgkmcnt(0)" ::: "memory"); \
                _Pragma("unroll") for (int d_ = 0; d_ < 4; ++d_) _Pragma("unroll") for (int r = 0; r < 16; ++r) o[d_][r] *= al_l[crow(r, hi)]; } \
            finishSM(p0, p1, alpha, l_reg, pa0, pa1, pa2, pa3); ATT_SBAR(); \
            pv_tile<BI>(o, vb0, pa0, pa1, pa2, pa3); \
        } } while (0)
    int bi = 0;
#pragma unroll 1
    for (int t = 0; t < NT; ++t) {
        const int kb = t * KVBLK;
        if (t + 2 < NT) { if (bi == 0) ATT_LOAD(t + 2, 2); else if (bi == 1) ATT_LOAD(t + 2, 0); else ATT_LOAD(t + 2, 1); }
        if (bi == 0) ATT_STEP(0); else if (bi == 1) ATT_STEP(1); else ATT_STEP(2);
        if (t + 2 < NT) asm volatile("s_waitcnt vmcnt(5)" ::: "memory"); else asm volatile("s_waitcnt vmcnt(0)" ::: "memory");
        LDS_BAR();
        bi = (bi == 2) ? 0 : bi + 1;
    }
#undef ATT_STEP
    if (hi == 0) li_l[r32] = l_reg; asm volatile("s_waitcnt lgkmcnt(0)" ::: "memory");
    bf16_t* Ow = AO + ((size_t)b * SEQ + qlo) * 1024 + h * 128;
#pragma unroll
    for (int r = 0; r < 16; ++r) { const int orow = crow(r, hi); const float rl = __builtin_amdgcn_rcpf(li_l[orow]);
#pragma unroll
        for (int d0 = 0; d0 < 4; ++d0) { const float v = o[d0][r] * rl; const float vn = swz<1>(v);
            if ((r32 & 1) == 0) *(unsigned*)(Ow + (size_t)orow * 1024 + d0 * 32 + r32) = cvt_pk_bf16(v, vn); } }
    __syncthreads();
#undef ATT_LOAD
}
}

namespace gdn {
constexpr int XS = 132;
constexpr int OFF_XQ = 0, OFF_XK = 64 * XS * 4, OFF_XV = 2 * 64 * XS * 4, OFF_LM = 3 * 64 * XS * 4, OFF_BETA = OFF_LM + 64 * 64 * 4, OFF_G = OFF_BETA + 256, OFF_EG = OFF_G + 256, OFF_TI = OFF_EG + 256;
__device__ __forceinline__ void prep_unit(LAS unsigned char* lds, const Params& p, int l, int unit) {
    int tid = threadIdx.x; asm volatile("" : "+v"(tid));
    const int wid = tid >> 6, lane = tid & 63;
    const int b = unit / (NH * NCH), h = (unit / NCH) % NH, n = unit % NCH;
    const int row0 = b * SEQ + n * CHK;
    LAS float* Xq = (LAS float*)(lds + OFF_XQ); LAS float* Xk = (LAS float*)(lds + OFF_XK); LAS float* Xv = (LAS float*)(lds + OFF_XV);
    LAS float* Lm = (LAS float*)(lds + OFF_LM); LAS float* beta = (LAS float*)(lds + OFF_BETA); LAS float* Gc = (LAS float*)(lds + OFF_G); LAS float* eG = (LAS float*)(lds + OFF_EG);
    const bf16_t* QKVG = (const bf16_t*)(p.ws + AR_QKVG); const float* BA = (const float*)(p.ws + WS_BA);
    bf16_t* U = (bf16_t*)(p.ws + WS_H); bf16_t* Wg = (bf16_t*)(p.ws + AR_WG); bf16_t* QG = (bf16_t*)(p.ws + AR_QG); bf16_t* KDT = (bf16_t*)(p.ws + AR_KDT); bf16_t* ATT = (bf16_t*)(p.ws + AR_ATT);
    float* EGL = (float*)(p.ws + WS_EGL);
#ifndef NO_CONV
    for (int rpc = 0; rpc < (PROBE_SEL == 7 ? 2 : 1); ++rpc)
    if (tid < 384) {
        const int cgp = tid % 48, rg = tid / 48, mat = cgp / 16, c8 = (cgp % 16) * 8, col = mat * 1024 + h * 128 + c8;
        float wj[4][8];
#pragma unroll
        for (int j = 0; j < 4; ++j) { const float* wp = p.conv_w + ((size_t)l * 4 + j) * 3072 + col; const f32x4 a = *(const f32x4*)wp, c = *(const f32x4*)(wp + 4);
            wj[j][0] = a[0]; wj[j][1] = a[1]; wj[j][2] = a[2]; wj[j][3] = a[3]; wj[j][4] = c[0]; wj[j][5] = c[1]; wj[j][6] = c[2]; wj[j][7] = c[3]; }
        float u[11][8];
#pragma unroll
        for (int k = 0; k < 11; ++k) { const int tt = n * CHK + rg * 8 - 3 + k;
            u32x4 w = {0u, 0u, 0u, 0u};
            if (tt >= 0) w = *(const u32x4*)(QKVG + (size_t)(b * SEQ + tt) * 3072 + col);
            u[k][0] = bflo(w[0]); u[k][1] = bfhi(w[0]); u[k][2] = bflo(w[1]); u[k][3] = bfhi(w[1]); u[k][4] = bflo(w[2]); u[k][5] = bfhi(w[2]); u[k][6] = bflo(w[3]); u[k][7] = bfhi(w[3]); }
        LAS float* X = (mat == 0) ? Xq : (mat == 1 ? Xk : Xv);
#pragma unroll
        for (int i = 0; i < 8; ++i) { f32x4 y0, y1;
#pragma unroll
            for (int c = 0; c < 8; ++c) { float y = wj[0][c] * u[i][c] + wj[1][c] * u[i + 1][c] + wj[2][c] * u[i + 2][c] + wj[3][c] * u[i + 3][c]; y = siluf_(y); if (c < 4) y0[c] = y; else y1[c - 4] = y; }
            *(LAS f32x4*)(X + (rg * 8 + i) * XS + c8) = y0; *(LAS f32x4*)(X + (rg * 8 + i) * XS + c8 + 4) = y1; }
    }
#endif
    LDS_BAR();
#pragma unroll
    for (int mat = 0; mat < 2; ++mat) { LAS float* X = (mat ? Xk : Xq) + (tid >> 3) * XS + (tid & 7) * 16;
        f32x4 v[4]; float s = 0.f;
#pragma unroll
        for (int j = 0; j < 4; ++j) { v[j] = *(const LAS f32x4*)(X + 4 * j); s += (v[j][0] * v[j][0] + v[j][1] * v[j][1]) + (v[j][2] * v[j][2] + v[j][3] * v[j][3]); }
        s += swz<1>(s); s += swz<2>(s); s += swz<4>(s);
        const float sc = rsqrtf(s + EPS) * (mat ? 1.0f : 0.08838834764831845f);
#pragma unroll
        for (int j = 0; j < 4; ++j) *(LAS f32x4*)(X + 4 * j) = v[j] * sc; }
    if (wid == 0) {
        const float bl = BA[(size_t)(row0 + lane) * 16 + h], al = BA[(size_t)(row0 + lane) * 16 + 8 + h];
        const float xx = al + p.dt_bias[l * NH + h];
        const float sp = fmaxf(xx, 0.f) + log1pf(__expf(-fabsf(xx)));
        const float g0 = -__expf(p.A_log[l * NH + h]) * sp;
        Gc[lane] = g0; asm volatile("s_waitcnt lgkmcnt(0)" ::: "memory");
        float g = 0.f;
#pragma unroll 8
        for (int j = 0; j < 64; ++j) { const float gj = Gc[j]; g += (j <= lane) ? gj : 0.f; }
        asm volatile("s_waitcnt lgkmcnt(0)" ::: "memory");
        beta[lane] = sigmoidf_(bl); eG[lane] = __expf(g); Gc[lane] = g;
        if (lane == 63) EGL[unit] = __expf(g);
    }
    LDS_BAR();
    for (int rp3 = 0; rp3 < (PROBE_SEL == 8 ? 2 : 1); ++rp3)
#pragma unroll 1
    for (int tt = 0; tt < 2; ++tt) { const int ti = wid * 2 + tt, it = ti >> 2, jt = ti & 3;
        f32x4 aKK = {0.f, 0.f, 0.f, 0.f}, aQK = {0.f, 0.f, 0.f, 0.f};
        if (jt <= it) {
            const LAS float* pk = Xk + (16 * it + (lane & 15)) * XS + (lane >> 4); const LAS float* pq = Xq + (16 * it + (lane & 15)) * XS + (lane >> 4);
            const LAS float* pb = Xk + (16 * jt + (lane & 15)) * XS + (lane >> 4);
#pragma unroll 8
            for (int d = 0; d < 128; d += 4) { const float ak = pk[d], aq = pq[d], bk = pb[d];
                aKK = __builtin_amdgcn_mfma_f32_16x16x4f32(ak, bk, aKK, 0, 0, 0); aQK = __builtin_amdgcn_mfma_f32_16x16x4f32(aq, bk, aQK, 0, 0, 0); }
        }
#pragma unroll
        for (int r = 0; r < 4; ++r) { const int ig = 16 * it + 4 * (lane >> 4) + r, jg = 16 * jt + (lane & 15);
            const float dec = (ig >= jg) ? __expf(Gc[ig] - Gc[jg]) : 0.f;
            Lm[ig * 64 + jg] = (ig > jg) ? beta[ig] * aKK[r] * dec : 0.f;
            ATT[(size_t)unit * 4096 + ig * 64 + jg] = f2bf(aQK[r] * dec); }
    }
    LDS_BAR();
    for (int rp4 = 0; rp4 < (PROBE_SEL == 9 ? 2 : 1); ++rp4)
    { const float Gl = Gc[63];
#pragma unroll
        for (int e = 0; e < 2; ++e) { const int idx = tid + NTHR * e, r = idx >> 4, c8 = (idx & 15) * 8; const float sc = eG[r];
            const f32x4 a = *(const LAS f32x4*)(Xq + r * XS + c8) * sc, c = *(const LAS f32x4*)(Xq + r * XS + c8 + 4) * sc;
            *(u32x4*)(QG + ((size_t)unit * 64 + r) * 128 + c8) = pack8u(a, c); }
#pragma unroll
        for (int e = 0; e < 2; ++e) { const int idx = tid + NTHR * e, dk = idx & 127, t8 = (idx >> 7) * 8; f32x4 a, c;
#pragma unroll
            for (int j = 0; j < 4; ++j) { a[j] = Xk[(t8 + j) * XS + dk] * __expf(Gl - Gc[t8 + j]); c[j] = Xk[(t8 + 4 + j) * XS + dk] * __expf(Gl - Gc[t8 + 4 + j]); }
            *(u32x4*)(KDT + ((size_t)unit * 128 + dk) * 64 + t8) = pack8u(a, c); } }
    LDS_BAR();
#pragma unroll
    for (int e = 0; e < 4; ++e) { const int idx = tid + NTHR * e, r = idx >> 5, c4 = (idx & 31) * 4; const float bt = beta[r], bw = bt * eG[r];
        *(LAS f32x4*)(Xv + r * XS + c4) = *(const LAS f32x4*)(Xv + r * XS + c4) * bt;
        *(LAS f32x4*)(Xq + r * XS + c4) = *(const LAS f32x4*)(Xk + r * XS + c4) * bw; }
    LAS float* TI = (LAS float*)(lds + OFF_TI);
    if (tid < 64) { const int Ib = tid >> 4, j = tid & 15; const LAS float* Lb = Lm + (16 * Ib) * 64 + 16 * Ib;
        float tv[16];
#pragma unroll
        for (int r = 0; r < 16; ++r) { float sacc = (r == j) ? 1.0f : 0.0f;
#pragma unroll
            for (int c4 = 0; c4 < (r + 3) / 4; ++c4) { const f32x4 L4 = *(const LAS f32x4*)(Lb + r * 64 + 4 * c4);
#pragma unroll
                for (int e = 0; e < 4; ++e) if (4 * c4 + e < r) sacc -= L4[e] * tv[4 * c4 + e]; }
            tv[r] = sacc; TI[(Ib * 16 + r) * 16 + j] = sacc; } }
    LDS_BAR();
    { LAS float* Xb0 = ((wid * 2) < 8 ? Xv : Xq) + ((wid * 2) & 7) * 16; LAS float* Xb1 = ((wid * 2 + 1) < 8 ? Xv : Xq) + ((wid * 2 + 1) & 7) * 16;
      const int li = lane & 15, lq = lane >> 4;
#pragma unroll 1
      for (int I = 0; I < 4; ++I) {
          f32x4 a0 = {0.f, 0.f, 0.f, 0.f}, a1 = {0.f, 0.f, 0.f, 0.f};
          const LAS float* pa = Lm + (16 * I + li) * 64 + lq;
#pragma unroll 4
          for (int kk = 0; kk < 16 * I; kk += 4) { const float av = pa[kk];
              a0 = __builtin_amdgcn_mfma_f32_16x16x4f32(av, Xb0[(kk + lq) * XS + li], a0, 0, 0, 0);
              a1 = __builtin_amdgcn_mfma_f32_16x16x4f32(av, Xb1[(kk + lq) * XS + li], a1, 0, 0, 0); }
#pragma unroll
          for (int r = 0; r < 4; ++r) { LAS float* x0 = Xb0 + (16 * I + 4 * lq + r) * XS + li; LAS float* x1 = Xb1 + (16 * I + 4 * lq + r) * XS + li; *x0 -= a0[r]; *x1 -= a1[r]; }
          asm volatile("s_waitcnt lgkmcnt(0)" ::: "memory");
          f32x4 y0 = {0.f, 0.f, 0.f, 0.f}, y1 = {0.f, 0.f, 0.f, 0.f};
          const LAS float* pt = TI + (I * 16 + li) * 16 + lq;
#pragma unroll
          for (int sx = 0; sx < 4; ++sx) { const float tvv = pt[4 * sx];
              y0 = __builtin_amdgcn_mfma_f32_16x16x4f32(tvv, Xb0[(16 * I + 4 * sx + lq) * XS + li], y0, 0, 0, 0);
              y1 = __builtin_amdgcn_mfma_f32_16x16x4f32(tvv, Xb1[(16 * I + 4 * sx + lq) * XS + li], y1, 0, 0, 0); }
#pragma unroll
          for (int r = 0; r < 4; ++r) { Xb0[(16 * I + 4 * lq + r) * XS + li] = y0[r]; Xb1[(16 * I + 4 * lq + r) * XS + li] = y1[r]; }
          asm volatile("s_waitcnt lgkmcnt(0)" ::: "memory");
      } }
    LDS_BAR();
#pragma unroll
    for (int e = 0; e < 4; ++e) { const int idx = tid + NTHR * e, r = idx >> 5, c4 = (idx & 31) * 4;
        *(u32x2*)(U + ((size_t)unit * 64 + r) * 128 + c4) = pack4u(*(const LAS f32x4*)(Xv + r * XS + c4));
        *(u32x2*)(Wg + ((size_t)unit * 64 + r) * 128 + c4) = pack4u(*(const LAS f32x4*)(Xq + r * XS + c4)); }
    LDS_BAR();
}

constexpr int SS = 136, VS = 72, OS = 132;
constexpr int OFF_ST = 0, OFF_VT = 128 * SS * 2, OFF_OT = OFF_VT + 128 * VS * 2, OFF_WQ = OFF_OT + 64 * OS * 4;
static_assert(OFF_WQ + 65536 <= MISC_OFF, "scan LDS");
__device__ __forceinline__ void scan_unit(LAS unsigned char* lds, const Params& p, int l, int bh) {
    int tid = threadIdx.x; asm volatile("" : "+v"(tid));
    const int wid = __builtin_amdgcn_readfirstlane(tid >> 6), lane = tid & 63, r32 = lane & 31, hi = lane >> 5;
    const int tm = wid & 1, tn = wid >> 1, b = bh / NH, h = bh % NH;
    LAS bf16_t* St = (LAS bf16_t*)(lds + OFF_ST); LAS bf16_t* Vt = (LAS bf16_t*)(lds + OFF_VT); LAS float* Ot = (LAS float*)(lds + OFF_OT);
    const bf16_t* U = (const bf16_t*)(p.ws + WS_H); const bf16_t* Wg = (const bf16_t*)(p.ws + AR_WG); const bf16_t* QG = (const bf16_t*)(p.ws + AR_QG);
    const bf16_t* KDT = (const bf16_t*)(p.ws + AR_KDT); const bf16_t* ATT = (const bf16_t*)(p.ws + AR_ATT); const float* EGL = (const float*)(p.ws + WS_EGL);
    const bf16_t* Z = (const bf16_t*)(p.ws + AR_Z); bf16_t* GO = (bf16_t*)(p.ws + AR_GO);
    f32x16 S0 = {}, S1 = {};
    for (int i = tid; i < 128 * SS / 2; i += NTHR) ((LAS unsigned*)St)[i] = 0u;
    LDS_BAR();
    const int gseg = tid & 7, gtok = tid >> 3;
    bf16x8 aa[4], ka[4], kb[4]; float uu[16]; u32x4 z0, z1;
    int dsrc[2];
#pragma unroll
    for (int i = 0; i < 2; ++i) { const int id = tid + i * NTHR, row = id >> 4, cc = id & 15; dsrc[i] = row * 128 + ((cc ^ (row & 7)) << 3); }
#define SCAN_DMA(cu_, bf_) do { const bf16_t* wsrc_ = Wg + (cu_) * 8192; const bf16_t* qsrc_ = QG + (cu_) * 8192; \
        _Pragma("unroll") for (int i = 0; i < 2; ++i) { \
            __builtin_amdgcn_global_load_lds((const unsigned*)(wsrc_ + dsrc[i]), (LAS unsigned*)(lds + OFF_WQ + (bf_) * 32768 + (i * NTHR + wid * 64) * 16), 16, 0, 0); \
            __builtin_amdgcn_global_load_lds((const unsigned*)(qsrc_ + dsrc[i]), (LAS unsigned*)(lds + OFF_WQ + (bf_) * 32768 + 16384 + (i * NTHR + wid * 64) * 16), 16, 0, 0); } } while (0)
#define SCAN_LD_U(cu_) do { const bf16_t* up = U + ((cu_) * 64 + 32 * tm) * 128 + 32 * tn + r32; _Pragma("unroll") for (int r = 0; r < 16; ++r) uu[r] = bf2f(up[(size_t)crow(r, hi) * 128]); } while (0)
#define SCAN_LD_AA(cu_) do { const bf16_t* ap = ATT + ((cu_) * 64 + 32 * tm + r32) * 64 + 8 * hi; \
        _Pragma("unroll") for (int ks = 0; ks < 4; ++ks) aa[ks] = *(const bf16x8*)(ap + 16 * ks); } while (0)
#define SCAN_LD_K(cu_) do { const bf16_t* k0 = KDT + ((cu_) * 128 + 64 * tm + r32) * 64 + 8 * hi; \
        _Pragma("unroll") for (int ks = 0; ks < 4; ++ks) { ka[ks] = *(const bf16x8*)(k0 + 16 * ks); kb[ks] = *(const bf16x8*)(k0 + 32 * 64 + 16 * ks); } } while (0)
#define SCAN_LD_Z(n_) do { const size_t go_ = ((size_t)b * SEQ + (n_) * CHK + gtok) * 1024 + h * 128 + gseg * 16; z0 = *(const u32x4*)(Z + go_); z1 = *(const u32x4*)(Z + go_ + 8); } while (0)
    LAS float* Gn = (LAS float*)(lds + OFF_WQ + 65536);
    if (tid < 128) Gn[tid] = p.gdn_norm[l * 128 + tid];
    { const size_t cu0 = (size_t)bh * NCH; SCAN_DMA(cu0, 0); SCAN_DMA(cu0 + 1, 1); SCAN_LD_U(cu0); SCAN_LD_K(cu0); SCAN_LD_Z(0); }
    asm volatile("s_waitcnt vmcnt(0)" ::: "memory");
    LDS_BAR();
    const int arow = (32 * tm + r32) * 256;
    int abase[4];
#pragma unroll
    for (int dd = 0; dd < 4; ++dd) abase[dd] = arow + (((2 * dd + hi) ^ (r32 & 7)) << 4);
#pragma unroll 1
    for (int n = 0; n < NCH; ++n) {
        const size_t cu = (size_t)bh * NCH + n;
        const int n1 = (n + 1 < NCH) ? n + 1 : NCH - 1, n2 = (n + 2 < NCH) ? n + 2 : NCH - 1;
        const size_t cu1 = (size_t)bh * NCH + n1, cu2 = (size_t)bh * NCH + n2;
        const float egl = EGL[cu];
        SCAN_LD_AA(cu);
        f32x16 aW = {}, aQ = {};
        { const LAS bf16_t* sp = St + (32 * tn + r32) * SS + 8 * hi; const LAS unsigned char* wq = lds + OFF_WQ + (n & 1) * 32768;
#pragma unroll
          for (int ks = 0; ks < 8; ++ks) { const bf16x8 sb = *(const LAS bf16x8*)(sp + 16 * ks);
              const bf16x8 wa = *(const LAS bf16x8*)(wq + abase[ks & 3] + (ks >> 2) * 128), qa = *(const LAS bf16x8*)(wq + 16384 + abase[ks & 3] + (ks >> 2) * 128);
              aW = __builtin_amdgcn_mfma_f32_32x32x16_bf16(wa, sb, aW, 0, 0, 0); aQ = __builtin_amdgcn_mfma_f32_32x32x16_bf16(qa, sb, aQ, 0, 0, 0); } }
#pragma unroll
        for (int r4 = 0; r4 < 4; ++r4) { f32x4 vn;
#pragma unroll
            for (int j = 0; j < 4; ++j) { const int r = 4 * r4 + j; vn[j] = uu[r] - aW[r]; }
            *(LAS u32x2*)(Vt + (32 * tn + r32) * VS + 32 * tm + 8 * r4 + 4 * hi) = pack4u(vn); }
        SCAN_LD_U(cu1);
        LDS_BAR();
        if (n & 1) SCAN_DMA(cu2, 1); else SCAN_DMA(cu2, 0);
        { const LAS bf16_t* vp = Vt + (32 * tn + r32) * VS + 8 * hi;
          S0 *= egl; S1 *= egl;
#pragma unroll
          for (int ks = 0; ks < 4; ++ks) { const bf16x8 vb = *(const LAS bf16x8*)(vp + 16 * ks);
              aQ = __builtin_amdgcn_mfma_f32_32x32x16_bf16(aa[ks], vb, aQ, 0, 0, 0);
              S0 = __builtin_amdgcn_mfma_f32_32x32x16_bf16(ka[ks], vb, S0, 0, 0, 0); S1 = __builtin_amdgcn_mfma_f32_32x32x16_bf16(kb[ks], vb, S1, 0, 0, 0); } }
        SCAN_LD_K(cu1);
#pragma unroll
        for (int r = 0; r < 16; ++r) Ot[(32 * tm + crow(r, hi)) * OS + 32 * tn + r32] = aQ[r];
#pragma unroll
        for (int r4 = 0; r4 < 4; ++r4) { const f32x4 a = {S0[4 * r4], S0[4 * r4 + 1], S0[4 * r4 + 2], S0[4 * r4 + 3]}, c = {S1[4 * r4], S1[4 * r4 + 1], S1[4 * r4 + 2], S1[4 * r4 + 3]};
            LAS bf16_t* sp = St + (32 * tn + r32) * SS + 64 * tm + 8 * r4 + 4 * hi;
            *(LAS u32x2*)sp = pack4u(a); *(LAS u32x2*)(sp + 32) = pack4u(c); }
        asm volatile("s_waitcnt vmcnt(28)" ::: "memory");
        LDS_BAR();
        { const LAS float* op = Ot + gtok * OS + gseg * 16; f32x4 ov[4]; float s = 0.f;
#pragma unroll
          for (int j = 0; j < 4; ++j) { ov[j] = *(const LAS f32x4*)(op + 4 * j); s += (ov[j][0] * ov[j][0] + ov[j][1] * ov[j][1]) + (ov[j][2] * ov[j][2] + ov[j][3] * ov[j][3]); }
          s += swz<1>(s); s += swz<2>(s); s += swz<4>(s);
          const float rs = rsqrtf(s * (1.0f / 128.0f) + EPS);
          const size_t go = ((size_t)b * SEQ + n * CHK + gtok) * 1024 + h * 128 + gseg * 16;
          float zf[16];
#pragma unroll
          for (int j = 0; j < 4; ++j) { zf[2 * j] = bflo(z0[j]); zf[2 * j + 1] = bfhi(z0[j]); zf[8 + 2 * j] = bflo(z1[j]); zf[8 + 2 * j + 1] = bfhi(z1[j]); }
          SCAN_LD_Z(n1);
          f32x4 q[4];
#pragma unroll
          for (int j = 0; j < 4; ++j) { const f32x4 gnj = *(const LAS f32x4*)(Gn + gseg * 16 + 4 * j);
#pragma unroll
              for (int e = 0; e < 4; ++e) q[j][e] = ov[j][e] * rs * gnj[e] * siluf_(zf[4 * j + e]); }
          *(u32x4*)(GO + go) = pack8u(q[0], q[1]); *(u32x4*)(GO + go + 8) = pack8u(q[2], q[3]); }
    }
    asm volatile("s_waitcnt vmcnt(0)" ::: "memory");
#undef SCAN_DMA
#undef SCAN_LD_U
#undef SCAN_LD_AA
#undef SCAN_LD_K
#undef SCAN_LD_Z
    LDS_BAR();
}
}

#define XB_TMO      128
#define XB_XCNT(j)  (256  + 64 * (j))
#define XB_XSUB(j)  (1280 + 64 * (j))
#define XB_XGEN(j)  (2304 + 64 * (j))
#define XB_TOP      3328
#define XB_TOPGEN   3392
#define XCD_BAR_WORDS 3456
#define XB_SPIN_CAP (1u << 18)
__device__ __forceinline__ unsigned xb_ld(unsigned* p)              { return __hip_atomic_load(p, __ATOMIC_RELAXED, __HIP_MEMORY_SCOPE_AGENT); }
__device__ __forceinline__ unsigned xb_add(unsigned* p, unsigned v) { return __hip_atomic_fetch_add(p, v, __ATOMIC_RELAXED, __HIP_MEMORY_SCOPE_AGENT); }
__device__ __forceinline__ unsigned xb_xcc_id() { return (unsigned)__builtin_amdgcn_s_getreg((3 << 11) | 20) & 0xFu; }
#define XB_SPIN(cond, bar) do { unsigned _sp = 0; while (cond) { __builtin_amdgcn_s_sleep(1); \
    if ((++_sp & 255u) == 0u) { if (xb_ld(&(bar)[XB_TMO])) break; if (_sp > XB_SPIN_CAP) { atomicAdd(&(bar)[XB_TMO], 1u); break; } } } } while (0)
struct XcdBarrier { unsigned* bar; unsigned x; volatile LAS unsigned* st; };
__device__ __forceinline__ XcdBarrier xcd_barrier_post(unsigned* bar, volatile LAS unsigned* st) {
    XcdBarrier b; b.bar = bar; b.x = xb_xcc_id(); b.st = st;
    if (threadIdx.x == 0) (void)xb_add(&bar[XB_XCNT(b.x)], 1u);
    return b;
}
__device__ __forceinline__ void xcd_barrier_complete(unsigned* bar, unsigned x, unsigned& nloc, unsigned& nx) {
    const unsigned G = gridDim.x * gridDim.y * gridDim.z;
    unsigned sum, cnt, mine, sp = 0u;
    for (;;) {
        sum = 0u; cnt = 0u; mine = 0u;
#pragma unroll
        for (unsigned j = 0; j < 16; ++j) { const unsigned c = xb_ld(&bar[XB_XCNT(j)]); sum += c; cnt += (c > 0u) ? 1u : 0u; mine = (j == x) ? c : mine; }
        if (sum == G) break;
        __builtin_amdgcn_s_sleep(1);
        if ((++sp & 255u) == 0u) { if (xb_ld(&bar[XB_TMO])) break; if (sp > XB_SPIN_CAP) { atomicAdd(&bar[XB_TMO], 1u); break; } }
    }
    nloc = mine > 0u ? mine : 1u; nx = cnt > 0u ? cnt : 1u;
}
__device__ __forceinline__ void xcd_barrier(const XcdBarrier& b) {
    asm volatile("s_waitcnt vmcnt(0)" ::: "memory");
    __syncthreads();
    if (threadIdx.x == 0) {
        unsigned* bar = b.bar;
        __builtin_amdgcn_s_waitcnt(0);
        unsigned nloc = b.st[0], nx = b.st[1];
        if (nloc == 0u) { xcd_barrier_complete(bar, b.x, nloc, nx); b.st[0] = nloc; b.st[1] = nx; }
        const unsigned old = xb_add(&bar[XB_XSUB(b.x)], 1u);
        const unsigned gen = old / nloc;
        if (old + 1u == (gen + 1u) * nloc) {
            __builtin_amdgcn_fence(__ATOMIC_RELEASE, "agent");
            asm volatile("s_waitcnt vmcnt(0)" ::: "memory");
            const unsigned og = xb_add(&bar[XB_TOP], 1u);
            const unsigned tg = og / nx;
            if (og + 1u == (tg + 1u) * nx) xb_add(&bar[XB_TOPGEN], 1u);
            else XB_SPIN(xb_ld(&bar[XB_TOPGEN]) == tg, bar);
            __builtin_amdgcn_fence(__ATOMIC_ACQUIRE, "agent");
            xb_add(&bar[XB_XGEN(b.x)], 1u);
            asm volatile("s_waitcnt vmcnt(0)" ::: "memory");
        } else {
            XB_SPIN(xb_ld(&bar[XB_XGEN(b.x)]) == gen, bar);
            __builtin_amdgcn_fence(__ATOMIC_ACQUIRE, "agent");
            asm volatile("s_waitcnt vmcnt(0)" ::: "memory");
        }
    }
    __syncthreads();
}

#ifndef PH_MASK
#define PH_MASK 0xFFFFF
#endif
#define PHE(k) ((PH_MASK >> (k)) & 1)
constexpr int NPHASE = 20;
__device__ __forceinline__ WDesc wdesc(const Params& p, int l, int i) {
    WDesc w; w.ksc = nullptr;
    switch (i) {
    case 0: w.src = p.w_in + (size_t)l * D * INW; w.dst = (bf16_t*)(p.ws + WS_WIN); w.K = D; w.Nsrc = INW; w.Ndst = INWP; w.type = WT_IN; break;
    case 1: w.src = p.w_uq + (size_t)l * 512 * 1536; w.dst = (bf16_t*)(p.ws + WS_WUQ); w.K = 512; w.Nsrc = 1536; w.Ndst = 1536; w.type = WT_UQ; w.ksc = p.q_a_norm + l * 512; break;
    case 2: w.src = p.w_ukv + (size_t)l * 512 * 2048; w.dst = (bf16_t*)(p.ws + WS_WUKV); w.K = 512; w.Nsrc = 2048; w.Ndst = 2048; w.type = WT_NAT; w.ksc = p.kv_a_norm + l * 512; break;
    case 3: w.src = p.w_o_mla + (size_t)l * 1024 * 2048; w.dst = (bf16_t*)(p.ws + WS_WOM); w.K = 1024; w.Nsrc = 2048; w.Ndst = 2048; w.type = WT_NAT; break;
    case 4: w.src = p.w_o_gdn + (size_t)l * 1024 * 2048; w.dst = (bf16_t*)(p.ws + WS_WOG); w.K = 1024; w.Nsrc = 2048; w.Ndst = 2048; w.type = WT_NAT; break;
    case 5: w.src = p.w_o + (size_t)l * 2048 * 2048; w.dst = (bf16_t*)(p.ws + WS_WO); w.K = 2048; w.Nsrc = 2048; w.Ndst = 2048; w.type = WT_NAT; break;
    case 6: w.src = p.w_gate_up + (size_t)l * 2048 * 11264; w.dst = (bf16_t*)(p.ws + AR_WGU); w.K = 2048; w.Nsrc = 11264; w.Ndst = 11264; w.type = WT_GU; break;
    default: w.src = p.w_down + (size_t)l * DFF * 2048; w.dst = (bf16_t*)(p.ws + AR_WDN); w.K = DFF; w.Nsrc = 2048; w.Ndst = 2048; w.type = WT_NAT; break;
    }
    return w;
}
__device__ __forceinline__ void conv_weights(LAS unsigned char* lds, const Params& p, int l, int i0, int i1, int skip) {
    int total = 0;
    for (int i = i0; i < i1; ++i) { const WDesc w = wdesc(p, l, i); total += wtiles(w); }
    int first = (int)blockIdx.x - (skip % (int)gridDim.x); if (first < 0) first += gridDim.x;
    for (int it = first; it < total; it += gridDim.x) {
        int it2 = it;
        for (int i = i0; i < i1; ++i) { const WDesc w = wdesc(p, l, i); const int n = wtiles(w); if (it2 < n) { conv_item(lds, w, it2); break; } it2 -= n; }
    }
}

__global__ void __launch_bounds__(NTHR) mega(Params p) {
    extern __shared__ __attribute__((aligned(16))) unsigned char smem[];
    LAS unsigned char* lds = (LAS unsigned char*)smem;
    cg::grid_group grid = cg::this_grid();
    unsigned char* ws = p.ws;
    float* MOD = (float*)(ws + WS_MOD); bf16_t* XA = (bf16_t*)(ws + WS_XA); bf16_t* H = (bf16_t*)(ws + WS_H);
    unsigned* ctr = (unsigned*)(ws + WS_CTL);
    volatile LAS unsigned* bst = (volatile LAS unsigned*)(lds + MISC_OFF + 16);
    if (threadIdx.x == 0) { bst[0] = 0u; bst[1] = 0u; }
    __syncthreads();
    const XcdBarrier xbar = xcd_barrier_post((unsigned*)(ws + WS_BAR), bst);
    for (int ph = p.ph_lo; ph < p.ph_hi; ++ph) {
        if (ph == 0) { if (PHE(0)) { for (int rp = 0; rp < (PROBE_SEL == 3 ? 2 : 1); ++rp) {
            { int t0 = threadIdx.x; asm volatile("" : "+v"(t0)); if (blockIdx.x == 0 && t0 < 64) ctr[t0] = 0u; }
            for (int it = blockIdx.x; it < 192 + 128; it += gridDim.x) { if (it < 192) ada_item(lds, p, it); else rope_item(p, it - 192); }
            conv_weights(lds, p, 0, 0, 6, 320); } }
        } else if (ph == NPHASE - 1) {
            if (PHE(10)) norm_rows<true, true>(nullptr, XA, p.final_norm, nullptr, 0, 0, nullptr, p.out);
        } else {
            const int l = (ph - 1) / 9, s = (ph - 1) % 9;
            const float* modl = MOD + (size_t)l * NB * 6 * D;
            switch (s) {
            case 0: if (PHE(1)) { if (l > 0) conv_weights(lds, p, l, 0, 6, 0);
                if (l == 0) norm_rows<false, false>(p.x, nullptr, p.norm_mix + l * D, modl, 0, 1, H, nullptr);
                else norm_rows<false, true>(nullptr, XA, p.norm_mix + l * D, modl, 0, 1, H, nullptr); } break;
            case 1: if (PHE(2)) { EpiIn e; e.CQ = (bf16_t*)(ws + AR_CQ); e.CKV = (bf16_t*)(ws + AR_CKV); e.QKVG = (bf16_t*)(ws + AR_QKVG); e.Z = (bf16_t*)(ws + AR_Z); e.GATE = (bf16_t*)(ws + AR_GATE);
                e.Kb = (bf16_t*)(ws + AR_K); e.SSQ = (float*)(ws + WS_SSQ); e.BA = (float*)(ws + WS_BA); e.COS = (const float*)(ws + WS_COS); e.SIN = (const float*)(ws + WS_SIN);
                pg8::gemm_phase(lds, pg8::Gemm{H, (const bf16_t*)(ws + WS_WIN), T, INWP, D}, e); } break;
            case 2: if (PHE(3)) { EpiQKV e; e.Q = (bf16_t*)(ws + AR_Q); e.Kb = (bf16_t*)(ws + AR_K); e.Vb = (bf16_t*)(ws + AR_V); e.SSQ = (const float*)(ws + WS_SSQ); e.COS = (const float*)(ws + WS_COS); e.SIN = (const float*)(ws + WS_SIN);
#ifndef NO_UP
#pragma unroll 1
                for (int g = 0; g < 2; ++g) { e.mode = g;
                    pg8::gemm_phase(lds, pg8::Gemm{(const bf16_t*)(ws + (g ? AR_CKV : AR_CQ)), (const bf16_t*)(ws + (g ? WS_WUKV : WS_WUQ)), T, g ? 2048 : 1536, 512}, e); }
#endif
#ifndef NO_PREP
                for (int rp = 0; rp < (PROBE_SEL == 2 ? 2 : 1); ++rp)
                for (int u = blockIdx.x; u < NB * NH * NCH; u += gridDim.x) gdn::prep_unit(lds, p, l, u);
#endif
                } break;
            case 3: if (PHE(4)) { for (int rp = 0; rp < (PROBE_SEL == 1 ? 2 : 1); ++rp) {
#if DBG_NO_SCAN
                { int t0 = threadIdx.x; asm volatile("" : "+v"(t0)); u32x4 z4 = {0u,0u,0u,0u}; for (size_t i = (size_t)blockIdx.x * NTHR + t0; i < (size_t)T * 1024 / 8; i += (size_t)gridDim.x * NTHR) ((u32x4*)(ws + AR_GO))[i] = z4; }
#else
                if (blockIdx.x < NB * NH) gdn::scan_unit(lds, p, l, blockIdx.x);
                if (PROBE_SEL == 5 && blockIdx.x < NB * NH) gdn::scan_unit(lds, p, l, blockIdx.x);
#endif
#if DBG_NO_ATT
                { int t0 = threadIdx.x; asm volatile("" : "+v"(t0)); u32x4 z4 = {0u,0u,0u,0u}; for (size_t i = (size_t)blockIdx.x * NTHR + t0; i < (size_t)T * 1024 / 8; i += (size_t)gridDim.x * NTHR) ((u32x4*)(ws + AR_AO))[i] = z4; }
#else
                LAS int* misc = (LAS int*)(lds + MISC_OFF);
                for (;;) { if (threadIdx.x == 0) misc[0] = (int)atomicAdd(ctr + l + 2 * rp, 1u);
                    __syncthreads(); const int i = misc[0]; __syncthreads();
                    if (i >= 512) break;
                    att::attn_unit(lds, (const bf16_t*)(ws + AR_Q), (const bf16_t*)(ws + AR_K), (const bf16_t*)(ws + AR_V), (bf16_t*)(ws + AR_AO), (i & 63) >> 3, i & 7, 7 - (i >> 6)); }
#endif
                } } break;
            case 4: if (PHE(5)) { EpiOut e; e.GATE = (const bf16_t*)(ws + AR_GATE); e.TMP = (float*)(ws + AR_TMP); e.MIX = (bf16_t*)(ws + AR_MIX);
#pragma unroll 1
                for (int g = 0; g < 2; ++g) { e.SECOND = g;
                    pg8::gemm_phase(lds, pg8::Gemm{(const bf16_t*)(ws + (g ? AR_GO : AR_AO)), (const bf16_t*)(ws + (g ? WS_WOG : WS_WOM)), T, 2048, 1024}, e); } } break;
            case 5: if (PHE(6)) { EpiResid e; e.XINF = (l == 0) ? p.x : nullptr; e.XIN16 = XA; e.XOUT = XA; e.GT = modl + 2 * D;
                pg8::gemm_phase(lds, pg8::Gemm{(const bf16_t*)(ws + AR_MIX), (const bf16_t*)(ws + WS_WO), T, 2048, 2048}, e); } break;
            case 6: if (PHE(7)) { for (int rp = 0; rp < (PROBE_SEL == 3 ? 2 : 1); ++rp) { conv_weights(lds, p, l, 6, 8, 0);
                norm_rows<false, true>(nullptr, XA, p.norm_ffn + l * D, modl, 3, 4, H, nullptr); } } break;
            case 7: if (PHE(8)) { EpiSwiGLU e; e.ACT = (bf16_t*)(ws + AR_ACT);
                pg8::gemm_phase(lds, pg8::Gemm{H, (const bf16_t*)(ws + AR_WGU), T, 11264, 2048}, e); } break;
            default: if (PHE(9)) { EpiResid e; e.XINF = nullptr; e.XIN16 = XA; e.XOUT = XA; e.GT = modl + 5 * D;
                pg8::gemm_phase(lds, pg8::Gemm{(const bf16_t*)(ws + AR_ACT), (const bf16_t*)(ws + AR_WDN), T, 2048, DFF}, e); } break;
            }
        }
        if (ph + 1 < p.ph_hi) { if (p.ph_hi < 0) grid.sync(); else xcd_barrier(xbar); }
    }
}

#ifndef MK_MULTI
#define MK_MULTI 0
#endif

#ifndef MK_REPS
#define MK_REPS 1
#endif
extern "C" void kernel_launch(void* const* d_in, const int* in_sizes, int n_in, void* d_out, int out_size, void* d_ws, size_t ws_size, hipStream_t stream) {
    static int grid = 0;
    if (grid == 0) {
        int dev = 0, cus = 0, per_cu = 0;
        (void)hipGetDevice(&dev);
        (void)hipDeviceGetAttribute(&cus, hipDeviceAttributeMultiprocessorCount, dev);
        if (hipFuncSetAttribute((const void*)mega, hipFuncAttributeMaxDynamicSharedMemorySize, LDS_BYTES) != hipSuccess) fprintf(stderr, "kernel_launch: hipFuncSetAttribute failed\n");
        if (hipOccupancyMaxActiveBlocksPerMultiprocessor(&per_cu, (const void*)mega, NTHR, LDS_BYTES) != hipSuccess || per_cu < 1) { fprintf(stderr, "kernel_launch: occupancy query says %d\n", per_cu); per_cu = 1; }
        (void)hipGetLastError();
        grid = cus * 1;
        if (grid <= 0) grid = 256;
        fprintf(stderr, "kernel_launch: grid %d (cus %d, per_cu %d), ws %zu need %zu\n", grid, cus, per_cu, ws_size, (size_t)WS_END);
    }
    if (ws_size < WS_END || n_in != 22) { (void)hipMemsetAsync(d_out, 0xFF, (size_t)out_size * 4, stream); return; }
    Params p{};
    p.x = (const float*)d_in[0]; p.c = (const float*)d_in[1]; p.pos = (const int*)d_in[2]; p.w_ada = (const float*)d_in[3]; p.b_ada = (const float*)d_in[4];
    p.norm_mix = (const float*)d_in[5]; p.norm_ffn = (const float*)d_in[6]; p.w_in = (const float*)d_in[7]; p.q_a_norm = (const float*)d_in[8]; p.kv_a_norm = (const float*)d_in[9];
    p.w_uq = (const float*)d_in[10]; p.w_ukv = (const float*)d_in[11]; p.w_o_mla = (const float*)d_in[12]; p.conv_w = (const float*)d_in[13]; p.A_log = (const float*)d_in[14];
    p.dt_bias = (const float*)d_in[15]; p.gdn_norm = (const float*)d_in[16]; p.w_o_gdn = (const float*)d_in[17]; p.w_o = (const float*)d_in[18]; p.w_gate_up = (const float*)d_in[19];
    p.w_down = (const float*)d_in[20]; p.final_norm = (const float*)d_in[21];
    p.out = (float*)d_out; p.ws = (unsigned char*)d_ws;
    (void)hipMemsetAsync((unsigned char*)d_ws + WS_BAR, 0, XCD_BAR_WORDS * 4, stream);
#if MK_MULTI
    for (int rep = 0; rep < MK_REPS; ++rep)
    for (int ph = 0; ph < NPHASE; ++ph) { p.ph_lo = ph; p.ph_hi = ph + 1; void* args[] = {&p};
        hipError_t e = hipLaunchCooperativeKernel((const void*)mega, dim3(grid), dim3(NTHR), args, LDS_BYTES, stream);
        if (e != hipSuccess) { fprintf(stderr, "cooperative launch failed: %s\n", hipGetErrorString(e)); break; } }
#else
    p.ph_lo = 0; p.ph_hi = NPHASE; void* args[] = {&p};
    hipError_t e = hipLaunchCooperativeKernel((const void*)mega, dim3(grid), dim3(NTHR), args, LDS_BYTES, stream);
    if (e != hipSuccess) fprintf(stderr, "cooperative launch failed: %s (grid %d)\n", hipGetErrorString(e), grid);
#endif
}
```

```cpp
#include <hip/hip_runtime.h>
#include <hip/hip_cooperative_groups.h>
#include <cstdio>
#include <cstdint>
namespace cg = cooperative_groups;
#define DBG_NO_ATT 0
#define DBG_NO_SCAN 0
#define PROBE_SEL 0

#define LAS __attribute__((address_space(3)))
typedef unsigned short bf16_t;
typedef short bf16x8 __attribute__((ext_vector_type(8)));
typedef short s16x4 __attribute__((ext_vector_type(4)));
typedef float f32x4 __attribute__((ext_vector_type(4)));
typedef float f32x16 __attribute__((ext_vector_type(16)));
typedef unsigned u32x4 __attribute__((ext_vector_type(4)));
typedef unsigned u32x2 __attribute__((ext_vector_type(2)));

constexpr int D = 2048, NB = 8, SEQ = 2048, T = NB * SEQ, DEPTH = 2;
constexpr int NH = 8, DQK = 192, QL = 512;
constexpr int CHK = 64, NCH = SEQ / CHK;
constexpr int DFF = 5632;
constexpr int INW = 9296, INWP = 9472;
constexpr float EPS = 1e-6f;
constexpr int NTHR = 512;
constexpr int LDS_BYTES = 156 * 1024;
constexpr int MISC_OFF = 155 * 1024;

constexpr size_t WS_CTL = 0;
constexpr size_t WS_BAR = 4096;
constexpr size_t WS_MOD = 32768;
constexpr size_t WS_COS = WS_MOD + (size_t)DEPTH * NB * 6 * D * 4;
constexpr size_t WS_SIN = WS_COS + (size_t)T * 32 * 4;
constexpr size_t WS_BA = WS_SIN + (size_t)T * 32 * 4;
constexpr size_t WS_SSQ = WS_BA + (size_t)T * 16 * 4;
constexpr size_t WS_EGL = WS_SSQ + (size_t)T * 16 * 4;
constexpr size_t WS_WIN = WS_EGL + 8192;
constexpr size_t WS_WUQ = WS_WIN + (size_t)INWP * D * 2;
constexpr size_t WS_WUKV = WS_WUQ + (size_t)1536 * 512 * 2;
constexpr size_t WS_WOM = WS_WUKV + (size_t)2048 * 512 * 2;
constexpr size_t WS_WOG = WS_WOM + (size_t)2048 * 1024 * 2;
constexpr size_t WS_WO = WS_WOG + (size_t)2048 * 1024 * 2;
constexpr size_t WS_XA = WS_WO + (size_t)2048 * 2048 * 2;
constexpr size_t WS_H = WS_XA + (size_t)T * D * 4;
constexpr size_t WS_AR = WS_H + (size_t)T * D * 2;
constexpr size_t AR_QKVG = WS_AR;
constexpr size_t AR_CQ = AR_QKVG + (size_t)T * 3072 * 2;
constexpr size_t AR_CKV = AR_CQ + (size_t)T * 512 * 2;
constexpr size_t AR_Z = AR_CKV + (size_t)T * 512 * 2;
constexpr size_t AR_GATE = AR_Z + (size_t)T * 1024 * 2;
constexpr size_t AR_Q = AR_GATE + (size_t)T * 4096 * 2;
constexpr size_t AR_K = AR_Q + (size_t)T * 1536 * 2;
constexpr size_t AR_V = AR_K + (size_t)T * 1536 * 2;
constexpr size_t AR_WG = AR_V + (size_t)T * 1024 * 2;
constexpr size_t AR_QG = AR_WG + (size_t)T * 1024 * 2;
constexpr size_t AR_KDT = AR_QG + (size_t)T * 1024 * 2;
constexpr size_t AR_ATT = AR_KDT + (size_t)T * 1024 * 2;
constexpr size_t AR_END = AR_ATT + (size_t)T * 8 * 64 * 2;
constexpr size_t AR_AO = AR_QKVG;
constexpr size_t AR_GO = AR_AO + (size_t)T * 1024 * 2;
constexpr size_t AR_TMP = AR_Q;
constexpr size_t AR_MIX = AR_WG;
constexpr size_t AR_ACT = WS_AR;
constexpr size_t AR_WGU = AR_ACT + (size_t)T * DFF * 2;
constexpr size_t AR_WDN = AR_WGU + (size_t)11264 * 2048 * 2;
constexpr size_t WS_END = AR_END;
static_assert(AR_WDN + (size_t)2048 * DFF * 2 <= AR_END, "ffn alias overflow");
static_assert(AR_TMP + (size_t)T * D * 4 <= AR_WG, "tmp alias");
static_assert(AR_MIX + (size_t)T * D * 2 <= AR_END, "mix alias");
static_assert(WS_END <= 846000000ull, "workspace");

struct Params {
    const float* x; const float* c; const int* pos; const float* w_ada; const float* b_ada; const float* norm_mix; const float* norm_ffn;
    const float* w_in; const float* q_a_norm; const float* kv_a_norm; const float* w_uq; const float* w_ukv; const float* w_o_mla;
    const float* conv_w; const float* A_log; const float* dt_bias; const float* gdn_norm; const float* w_o_gdn; const float* w_o;
    const float* w_gate_up; const float* w_down; const float* final_norm;
    float* out; unsigned char* ws; int ph_lo, ph_hi;
};

__constant__ float c_inv_freq[32] = {1.000000000e+00f, 7.498942018e-01f, 5.623413324e-01f, 4.216965139e-01f, 3.162277639e-01f, 2.371373773e-01f, 1.778279394e-01f, 1.333521456e-01f,
    1.000000015e-01f, 7.498942316e-02f, 5.623413250e-02f, 4.216964915e-02f, 3.162277490e-02f, 2.371373773e-02f, 1.778279431e-02f, 1.333521400e-02f,
    9.999999776e-03f, 7.498942316e-03f, 5.623413250e-03f, 4.216964822e-03f, 3.162277630e-03f, 2.371373819e-03f, 1.778279431e-03f, 1.333521446e-03f,
    1.000000047e-03f, 7.498941850e-04f, 5.623413017e-04f, 4.216965172e-04f, 3.162277571e-04f, 2.371373703e-04f, 1.778279402e-04f, 1.333521504e-04f};

typedef __bf16 bf16v2_t __attribute__((ext_vector_type(2)));
typedef float f32v2_t __attribute__((ext_vector_type(2)));
__device__ __forceinline__ unsigned cvt_pk_bf16(float lo, float hi) { const bf16v2_t r = __builtin_convertvector((f32v2_t){lo, hi}, bf16v2_t); return __builtin_bit_cast(unsigned, r); }
__device__ __forceinline__ bf16_t f2bf(float f) { unsigned u = __float_as_uint(f); u += 0x7FFFu + ((u >> 16) & 1u); return (bf16_t)(u >> 16); }
__device__ __forceinline__ float bf2f(bf16_t b) { return __uint_as_float(((unsigned)b) << 16); }
__device__ __forceinline__ float bflo(unsigned w) { return __uint_as_float(w << 16); }
__device__ __forceinline__ float bfhi(unsigned w) { return __uint_as_float(w & 0xffff0000u); }
__device__ __forceinline__ u32x4 pack8u(f32x4 a, f32x4 b) { u32x4 w = {cvt_pk_bf16(a[0], a[1]), cvt_pk_bf16(a[2], a[3]), cvt_pk_bf16(b[0], b[1]), cvt_pk_bf16(b[2], b[3])}; return w; }
__device__ __forceinline__ u32x2 pack4u(f32x4 a) { u32x2 w = {cvt_pk_bf16(a[0], a[1]), cvt_pk_bf16(a[2], a[3])}; return w; }
__device__ __forceinline__ float sigmoidf_(float x) { return __builtin_amdgcn_rcpf(1.0f + __expf(-x)); }
__device__ __forceinline__ float siluf_(float x) { return x * __builtin_amdgcn_rcpf(1.0f + __expf(-x)); }
template <int M> __device__ __forceinline__ float swz(float v) { return __int_as_float(__builtin_amdgcn_ds_swizzle(__float_as_int(v), (M << 10) | 0x1F)); }
__device__ __forceinline__ float halfsum(float v) { auto rr = __builtin_amdgcn_permlane32_swap(__float_as_uint(v), __float_as_uint(v), false, false); return __uint_as_float(rr[0]) + __uint_as_float(rr[1]); }
__device__ __forceinline__ float wave_sum(float s) { s += swz<1>(s); s += swz<2>(s); s += swz<4>(s); s += swz<8>(s); s += swz<16>(s); return halfsum(s); }
__device__ __forceinline__ int crow(int r, int hi) { return (r & 3) + 8 * (r >> 2) + 4 * hi; }
__device__ __forceinline__ int ropeperm(int j) { const int g = j >> 3, w = j & 7; return (w < 4) ? (4 * g + w) : (32 + 4 * g + (w - 4)); }

namespace pg8 {
constexpr int BM = 256, BK = 64, HALF = 128, HTB = HALF * BK * 2, STAGE_BYTES = 8 * HTB, NXCD = 8, WGM = 8;
__host__ __device__ __forceinline__ int lds_byte(int r, int c) { const int st = (r >> 4) * 2 + (c >> 5), rr = r & 15, cc = c & 31, ob = rr * 64 + cc * 2; return st * 1024 + (ob ^ (((ob >> 9) & 1) << 5)); }
__host__ __device__ __forceinline__ void stage_rc(int b, int& R, int& C) { const int st = b / 1024, sb = b % 1024, swz = sb ^ (((sb >> 9) & 1) << 5); R = (st >> 1) * 16 + swz / 64; C = (st & 1) * 32 + (swz % 64) / 2; }
__host__ __device__ __forceinline__ int perm32(int rho) { const int n = rho >> 4, i = rho & 15; return 8 * (i >> 2) + 4 * n + (i & 3); }
struct Unit { int pm, pn; };
struct Gemm { const bf16_t* A; const bf16_t* Bt; int M, N, K; };
struct StaticOrder {
    int nM, nN, nwg, G, c;
    __device__ void init(int M, int N, int G_, int c_) { nM = M / BM; nN = N / BM; nwg = nM * nN; G = G_; c = c_; }
    __device__ bool next(int i, Unit& u) const {
        const long L = (long)i * G + c; if (L >= nwg) return false;
        int wgid = (int)L; { const int q = nwg / NXCD, r = nwg % NXCD, xcd = wgid % NXCD, off = wgid / NXCD; wgid = (xcd < r ? xcd * (q + 1) : r * (q + 1) + (xcd - r) * q) + off; }
        const int nig = WGM * nN, gid = wgid / nig, fm = gid * WGM, gsz = (nM - fm) < WGM ? (nM - fm) : WGM;
        u.pm = fm + ((wgid % nig) % gsz); u.pn = (wgid % nig) / gsz; return true;
    }
};
template <class Epi>
__device__ __forceinline__ void gemm_phase(LAS unsigned char* lds, const Gemm g, const Epi& E) {
    int tid = threadIdx.x; asm volatile("" : "+v"(tid));
    int bid = blockIdx.x; asm volatile("" : "+s"(bid));
    StaticOrder S; S.init(g.M, g.N, (int)gridDim.x, bid);
    const int wid = __builtin_amdgcn_readfirstlane(tid >> 6), lane = tid & 63, wr = wid >> 2, wc = wid & 3, fr = lane & 15, fq = lane >> 4;
    const int K = g.K, nt = K / BK;
    unsigned voffA[2], voffB[2];
#pragma unroll
    for (int i = 0; i < 2; ++i) { int R, C; stage_rc(tid * 16 + i * 8192, R, C); const int Rb = Epi::PERM ? ((R & ~31) + perm32(R & 31)) : R;
        voffA[i] = (unsigned)(R * K + C) * 2u; voffB[i] = (unsigned)(Rb * K + C) * 2u; }
    const size_t kstep = (size_t)(BK * 2);
    const size_t hstep = (size_t)HALF * K * 2;
    const size_t tstep = 2 * hstep;
    const unsigned ldsw = (unsigned)wid * 1024u;
    const int aoff = lds_byte(wr * 64 + fr, fq * 8), boff = lds_byte(wc * 32 + fr, fq * 8);
#define PG8_SA(b, h) (((b) * 2 + (h)) * HTB)
#define PG8_SB(b, h) ((4 + (b) * 2 + (h)) * HTB)
#define PG8_STAGE(bufoff, gbase, voff) do { _Pragma("unroll") for (int _i = 0; _i < 2; ++_i) \
        __builtin_amdgcn_global_load_lds((const unsigned*)((const char*)(gbase) + (voff)[_i]), (LAS unsigned*)(lds + (bufoff) + ldsw + _i * 8192), 16, 0, 0); } while (0)
#define PG8_LDA(dst, b, h) do { _Pragma("unroll") for (int m = 0; m < 4; ++m) _Pragma("unroll") for (int k = 0; k < 2; ++k) dst[m][k] = *(const LAS bf16x8*)(lds + PG8_SA(b, h) + aoff + m * 2048 + k * 1024); } while (0)
#define PG8_LDB(dst, b, h) do { _Pragma("unroll") for (int n = 0; n < 2; ++n) _Pragma("unroll") for (int k = 0; k < 2; ++k) dst[n][k] = *(const LAS bf16x8*)(lds + PG8_SB(b, h) + boff + n * 2048 + k * 1024); } while (0)
#define PG8_MMA(ai, bj, At, Bt) do { __builtin_amdgcn_s_setprio(1); _Pragma("unroll") for (int m = 0; m < 4; ++m) _Pragma("unroll") for (int n = 0; n < 2; ++n) _Pragma("unroll") for (int k = 0; k < 2; ++k) \
        acc[ai][bj][m][n] = __builtin_amdgcn_mfma_f32_16x16x32_bf16(Bt[n][k], At[m][k], acc[ai][bj][m][n], 0, 0, 0); __builtin_amdgcn_s_setprio(0); } while (0)
#define PG8_WAIT_V(n) asm volatile("s_waitcnt vmcnt(" #n ")" ::: "memory")
#define PG8_WAIT_L(n) asm volatile("s_waitcnt lgkmcnt(" #n ")" ::: "memory")
#define PG8_BAR __builtin_amdgcn_s_barrier()
#define PG8_SCHED __builtin_amdgcn_sched_barrier(0)
    Unit cur, nxt; int ui = 0;
    if (S.next(0, cur)) {
    f32x4 acc[2][2][4][2];
#pragma unroll
    for (int a = 0; a < 2; ++a)
#pragma unroll
        for (int b = 0; b < 2; ++b)
#pragma unroll
            for (int m = 0; m < 4; ++m)
#pragma unroll
                for (int n = 0; n < 2; ++n) acc[a][b][m][n] = (f32x4){0.f, 0.f, 0.f, 0.f};
    bf16x8 At[4][2], B0[2][2], B1[2][2];
    const char* cA = (const char*)g.A + (size_t)cur.pm * tstep; const char* cB = (const char*)g.Bt + (size_t)cur.pn * tstep;
    PG8_STAGE(PG8_SB(0, 0), cB, voffB); PG8_STAGE(PG8_SA(0, 0), cA, voffA); PG8_STAGE(PG8_SB(0, 1), cB + hstep, voffB); PG8_STAGE(PG8_SA(0, 1), cA + hstep, voffA);
    if (wr == 1) PG8_BAR;
    PG8_WAIT_V(4); PG8_BAR;
    PG8_STAGE(PG8_SB(1, 0), cB + kstep, voffB); PG8_STAGE(PG8_SA(1, 0), cA + kstep, voffA); PG8_STAGE(PG8_SB(1, 1), cB + hstep + kstep, voffB);
    PG8_WAIT_V(6); PG8_BAR;
    for (;;) {
        const bool has_next = S.next(ui + 1, nxt);
        const char* nA = has_next ? (const char*)g.A + (size_t)nxt.pm * tstep : cA; const char* nB = has_next ? (const char*)g.Bt + (size_t)nxt.pn * tstep : cB;
        for (int t = 0; t < nt; t += 2) {
            const bool last = (t == nt - 2);
            const char* a1 = cA + (size_t)(t + 1) * kstep;
            const char* a2 = last ? nA : cA + (size_t)(t + 2) * kstep; const char* b2 = last ? nB : cB + (size_t)(t + 2) * kstep;
            const char* a3 = a2 + kstep; const char* b3 = b2 + kstep;
            PG8_LDB(B0, 0, 0); PG8_SCHED; PG8_LDA(At, 0, 0); PG8_STAGE(PG8_SA(1, 1), a1 + hstep, voffA);
            PG8_WAIT_L(8); PG8_BAR; PG8_WAIT_L(0); PG8_MMA(0, 0, At, B0); PG8_BAR; PG8_SCHED;
            PG8_LDB(B1, 0, 1); PG8_STAGE(PG8_SB(0, 0), b2, voffB);
            PG8_BAR; PG8_WAIT_L(0); PG8_MMA(0, 1, At, B1); PG8_BAR;
            PG8_LDA(At, 0, 1); PG8_STAGE(PG8_SA(0, 0), a2, voffA);
            PG8_BAR; PG8_WAIT_L(0); PG8_MMA(1, 0, At, B0); PG8_BAR; PG8_SCHED;
            PG8_STAGE(PG8_SB(0, 1), b2 + hstep, voffB);
            PG8_WAIT_V(6); PG8_BAR; PG8_MMA(1, 1, At, B1); PG8_BAR;
            PG8_LDB(B0, 1, 0); PG8_SCHED; PG8_LDA(At, 1, 0); PG8_STAGE(PG8_SA(0, 1), a2 + hstep, voffA);
            PG8_WAIT_L(8); PG8_BAR; PG8_WAIT_L(0); PG8_MMA(0, 0, At, B0); PG8_BAR; PG8_SCHED;
            PG8_LDB(B1, 1, 1); PG8_STAGE(PG8_SB(1, 0), b3, voffB);
            PG8_BAR; PG8_WAIT_L(0); PG8_MMA(0, 1, At, B1); PG8_BAR;
            PG8_LDA(At, 1, 1); PG8_STAGE(PG8_SA(1, 0), a3, voffA);
            PG8_BAR; PG8_WAIT_L(0); PG8_MMA(1, 0, At, B0); PG8_BAR; PG8_SCHED;
            PG8_STAGE(PG8_SB(1, 1), b3 + hstep, voffB);
            PG8_WAIT_V(6); PG8_BAR; PG8_MMA(1, 1, At, B1); PG8_BAR;
        }
        E(acc, cur, wr, wc, fr, fq);
        if (!has_next) break;
#pragma unroll
        for (int a = 0; a < 2; ++a)
#pragma unroll
            for (int b = 0; b < 2; ++b)
#pragma unroll
                for (int m = 0; m < 4; ++m)
#pragma unroll
                    for (int n = 0; n < 2; ++n) acc[a][b][m][n] = (f32x4){0.f, 0.f, 0.f, 0.f};
        cur = nxt; cA = nA; cB = nB; ++ui;
    }
    PG8_WAIT_V(0);
    if (wr == 0) PG8_BAR;
    PG8_BAR;
    }
    __syncthreads();
#undef PG8_SA
#undef PG8_SB
#undef PG8_STAGE
#undef PG8_LDA
#undef PG8_LDB
#undef PG8_MMA
#undef PG8_WAIT_V
#undef PG8_WAIT_L
#undef PG8_BAR
#undef PG8_SCHED
}
}
using pg8::Unit;
typedef f32x4 AccT[2][2][4][2];

struct EpiIn {
    static constexpr bool PERM = true;
    bf16_t* CQ; bf16_t* CKV; bf16_t* QKVG; bf16_t* Z; bf16_t* GATE; bf16_t* Kb; float* SSQ; float* BA; const float* COS; const float* SIN;
    __device__ __forceinline__ void operator()(const AccT& acc, const Unit& u, int wr, int wc, int fr, int fq) const {
        const int pn = u.pn;
        if (pn < 36) {
            bf16_t* base; int ld;
            if (pn < 4) { base = (pn < 2 ? CQ : CKV) + (pn & 1) * 256; ld = 512; }
            else if (pn < 16) { base = QKVG + (pn - 4) * 256; ld = 3072; }
            else if (pn < 20) { base = Z + (pn - 16) * 256; ld = 1024; }
            else { base = GATE + (pn - 20) * 256; ld = 4096; }
            base += wc * 32 + fq * 8;
#pragma unroll
            for (int ai = 0; ai < 2; ++ai)
#pragma unroll
                for (int m = 0; m < 4; ++m) {
                    const int row = u.pm * 256 + ai * 128 + wr * 64 + m * 16 + fr;
                    bf16_t* dst = base + (size_t)row * ld; float s = 0.f;
#pragma unroll
                    for (int bj = 0; bj < 2; ++bj) { f32x4 v0 = acc[ai][bj][m][0], v1 = acc[ai][bj][m][1];
                        if (pn < 4) s += (v0[0] * v0[0] + v0[1] * v0[1]) + (v0[2] * v0[2] + v0[3] * v0[3]) + (v1[0] * v1[0] + v1[1] * v1[1]) + (v1[2] * v1[2] + v1[3] * v1[3]);
                        if (pn >= 20) {
#pragma unroll
                            for (int j = 0; j < 4; ++j) { v0[j] = sigmoidf_(v0[j]); v1[j] = sigmoidf_(v1[j]); } }
                        *(u32x4*)(dst + bj * 128) = pack8u(v0, v1); }
                    if (pn < 4) { s += swz<16>(s); s = halfsum(s); if (fq == 0) SSQ[(size_t)row * 16 + pn * 4 + wc] = s; }
                }
        } else {
            const int g8 = wc * 4 + fq;
#pragma unroll
            for (int ai = 0; ai < 2; ++ai)
#pragma unroll
                for (int m = 0; m < 4; ++m) {
                    const int row = u.pm * 256 + ai * 128 + wr * 64 + m * 16 + fr;
                    const f32x4 v0 = acc[ai][0][m][0], v1 = acc[ai][0][m][1];
                    if (g8 < 8) {
                        const int i0 = 4 * g8;
                        const f32x4 cs = *(const f32x4*)(COS + (size_t)row * 32 + i0), sn = *(const f32x4*)(SIN + (size_t)row * 32 + i0);
                        const f32x4 o1 = v0 * cs - v1 * sn, o2 = v1 * cs + v0 * sn;
                        const u32x2 w1 = pack4u(o1), w2 = pack4u(o2);
                        const int b = row / SEQ, t = row % SEQ;
                        bf16_t* kp = Kb + ((size_t)(b * NH) * SEQ + t) * DQK + 128 + i0;
#pragma unroll
                        for (int h = 0; h < NH; ++h) { *(u32x2*)(kp + (size_t)h * SEQ * DQK) = w1; *(u32x2*)(kp + (size_t)h * SEQ * DQK + 32) = w2; }
                    } else if (g8 < 10) { float* bp = BA + (size_t)row * 16 + (g8 - 8) * 8; *(f32x4*)bp = v0; *(f32x4*)(bp + 4) = v1; }
                }
        }
    }
};
struct EpiQKV {
    static constexpr bool PERM = true;
    bf16_t* Q; bf16_t* Kb; bf16_t* Vb; const float* SSQ; const float* COS; const float* SIN; int mode;
    __device__ __forceinline__ void operator()(const AccT& acc, const Unit& u, int wr, int wc, int fr, int fq) const {
#pragma unroll
        for (int ai = 0; ai < 2; ++ai)
#pragma unroll
            for (int m = 0; m < 4; ++m) {
                const int row = u.pm * 256 + ai * 128 + wr * 64 + m * 16 + fr; const int b = row / SEQ, t = row % SEQ;
                const f32x4 s0 = *(const f32x4*)(SSQ + (size_t)row * 16 + mode * 8), s1 = *(const f32x4*)(SSQ + (size_t)row * 16 + mode * 8 + 4);
                const float ssq = (s0[0] + s0[1]) + (s0[2] + s0[3]) + (s1[0] + s1[1]) + (s1[2] + s1[3]);
                float rs = rsqrtf(ssq * (1.0f / 512.0f) + EPS);
                if (mode == 0) {
                    rs *= (0.07216878364870322f * 1.4426950408889634f);
#pragma unroll
                    for (int bj = 0; bj < 2; ++bj) {
                        const int c8 = u.pn * 256 + bj * 128 + wc * 32 + fq * 8; const int head = c8 / DQK, d0 = c8 % DQK;
                        bf16_t* qp = Q + ((size_t)(b * NH + head) * SEQ + t) * DQK;
                        const f32x4 v0 = acc[ai][bj][m][0] * rs, v1 = acc[ai][bj][m][1] * rs;
                        if (d0 < 128) { *(u32x4*)(qp + d0) = pack8u(v0, v1); }
                        else { const int i0 = 4 * ((d0 - 128) >> 3);
                            const f32x4 cs = *(const f32x4*)(COS + (size_t)row * 32 + i0), sn = *(const f32x4*)(SIN + (size_t)row * 32 + i0);
                            const f32x4 o1 = v0 * cs - v1 * sn, o2 = v1 * cs + v0 * sn;
                            *(u32x2*)(qp + 128 + i0) = pack4u(o1); *(u32x2*)(qp + 160 + i0) = pack4u(o2); }
                    }
                } else {
                    const size_t bh = (size_t)(b * NH + u.pn) * SEQ + t; const int d = wc * 32 + fq * 8;
                    *(u32x4*)(Kb + bh * DQK + d) = pack8u(acc[ai][0][m][0] * rs, acc[ai][0][m][1] * rs);
                    *(u32x4*)(Vb + bh * 128 + d) = pack8u(acc[ai][1][m][0] * rs, acc[ai][1][m][1] * rs);
                }
            }
    }
};
struct EpiOut {
    static constexpr bool PERM = true;
    const bf16_t* GATE; float* TMP; bf16_t* MIX; int SECOND;
    __device__ __forceinline__ void operator()(const AccT& acc, const Unit& u, int wr, int wc, int fr, int fq) const {
#pragma unroll
        for (int ai = 0; ai < 2; ++ai)
#pragma unroll
            for (int m = 0; m < 4; ++m) {
                const int row = u.pm * 256 + ai * 128 + wr * 64 + m * 16 + fr;
#pragma unroll
                for (int bj = 0; bj < 2; ++bj) {
                    const int c8 = u.pn * 256 + bj * 128 + wc * 32 + fq * 8;
                    const u32x4 gw = *(const u32x4*)(GATE + (size_t)row * 4096 + SECOND * 2048 + c8);
                    const f32x4 g0 = {bflo(gw[0]), bfhi(gw[0]), bflo(gw[1]), bfhi(gw[1])}, g1 = {bflo(gw[2]), bfhi(gw[2]), bflo(gw[3]), bfhi(gw[3])};
                    bf16_t* tp = (bf16_t*)TMP + (size_t)row * 2048 + c8;
                    if (SECOND == 0) { *(u32x4*)tp = pack8u(g0 * acc[ai][bj][m][0], g1 * acc[ai][bj][m][1]); }
                    else { const u32x4 tw = *(const u32x4*)tp;
                        const f32x4 t0 = {bflo(tw[0]), bfhi(tw[0]), bflo(tw[1]), bfhi(tw[1])}, t1 = {bflo(tw[2]), bfhi(tw[2]), bflo(tw[3]), bfhi(tw[3])};
                        const f32x4 a0 = t0 + g0 * acc[ai][bj][m][0], a1 = t1 + g1 * acc[ai][bj][m][1];
                        *(u32x4*)(MIX + (size_t)row * 2048 + c8) = pack8u(a0, a1); }
                }
            }
    }
};
struct EpiResid {
    static constexpr bool PERM = true;
    const float* XINF; const bf16_t* XIN16; bf16_t* XOUT; const float* GT;
    __device__ __forceinline__ void operator()(const AccT& acc, const Unit& u, int wr, int wc, int fr, int fq) const {
        const int b = (u.pm * 256) / SEQ;
        f32x4 gt[2][2];
#pragma unroll
        for (int bj = 0; bj < 2; ++bj)
#pragma unroll
            for (int n = 0; n < 2; ++n) gt[bj][n] = *(const f32x4*)(GT + (size_t)b * 6 * D + u.pn * 256 + bj * 128 + wc * 32 + fq * 8 + 4 * n);
#pragma unroll
        for (int ai = 0; ai < 2; ++ai)
#pragma unroll
            for (int m = 0; m < 4; ++m) {
                const int row = u.pm * 256 + ai * 128 + wr * 64 + m * 16 + fr;
#pragma unroll
                for (int bj = 0; bj < 2; ++bj) {
                    const size_t off = (size_t)row * D + u.pn * 256 + bj * 128 + wc * 32 + fq * 8;
                    f32x4 x0, x1;
                    if (XINF) { x0 = *(const f32x4*)(XINF + off); x1 = *(const f32x4*)(XINF + off + 4); }
                    else { const u32x4 w = *(const u32x4*)(XIN16 + off); x0 = (f32x4){bflo(w[0]), bfhi(w[0]), bflo(w[1]), bfhi(w[1])}; x1 = (f32x4){bflo(w[2]), bfhi(w[2]), bflo(w[3]), bfhi(w[3])}; }
                    *(u32x4*)(XOUT + off) = pack8u(x0 + gt[bj][0] * acc[ai][bj][m][0], x1 + gt[bj][1] * acc[ai][bj][m][1]);
                }
            }
    }
};
struct EpiSwiGLU {
    static constexpr bool PERM = true;
    bf16_t* ACT;
    __device__ __forceinline__ void operator()(const AccT& acc, const Unit& u, int wr, int wc, int fr, int fq) const {
#pragma unroll
        for (int ai = 0; ai < 2; ++ai)
#pragma unroll
            for (int m = 0; m < 4; ++m) {
                const int row = u.pm * 256 + ai * 128 + wr * 64 + m * 16 + fr;
                f32x4 o0, o1;
#pragma unroll
                for (int j = 0; j < 4; ++j) { o0[j] = siluf_(acc[ai][0][m][0][j]) * acc[ai][1][m][0][j]; o1[j] = siluf_(acc[ai][0][m][1][j]) * acc[ai][1][m][1][j]; }
                *(u32x4*)(ACT + (size_t)row * DFF + u.pn * 128 + wc * 32 + fq * 8) = pack8u(o0, o1);
            }
    }
};

enum { WT_IN = 0, WT_UQ, WT_UKV, WT_NAT, WT_GU };
__device__ __forceinline__ int wsrc_col(int type, int n) {
    switch (type) {
    case WT_IN: { const int pn = n >> 8, j = n & 255;
        if (pn < 4) return n;
        if (pn < 20) return 1088 + (n - 1024);
        if (pn < 36) return 5200 + (n - 5120);
        if (j < 64) return 1024 + ropeperm(j);
        if (j < 72) return 5184 + (j - 64);
        if (j < 80) return 5192 + (j - 72);
        return -1; }
    case WT_UQ: { const int h = n / DQK, d = n % DQK; return d < 128 ? n : h * DQK + 128 + ropeperm(d - 128); }
    case WT_GU: { const int pn = n >> 8, j = n & 255; return (j >> 7) * DFF + pn * 128 + (j & 127); }
    default: return n;
    }
}
__device__ __forceinline__ void conv_tile(LAS unsigned char* lds, const float* __restrict__ src, int Nsrc, bf16_t* __restrict__ dst, int K, int type, const float* __restrict__ ksc, int kt, int nt) {
    LAS bf16_t* tile = (LAS bf16_t*)lds;
    int tid = threadIdx.x; asm volatile("" : "+v"(tid));
    const int n4 = (tid & 63) * 4, kr = tid >> 6;
    const int sc = wsrc_col(type, nt * 256 + n4);
    f32x4 v[8];
#pragma unroll
    for (int i = 0; i < 8; ++i) { const int k = kt * 64 + kr + 8 * i; v[i] = (f32x4){0.f, 0.f, 0.f, 0.f};
        if (sc >= 0) { v[i] = *(const f32x4*)(src + (size_t)k * Nsrc + sc); if (ksc) v[i] *= ksc[k]; } }
#pragma unroll
    for (int i = 0; i < 8; ++i) {
#pragma unroll
        for (int j = 0; j < 4; ++j) tile[(n4 + j) * 72 + kr + 8 * i] = f2bf(v[i][j]); }
    __syncthreads();
#pragma unroll
    for (int e = 0; e < 4; ++e) { const int id = tid + e * NTHR, n2 = id >> 3, kc = id & 7;
        const u32x4 w = *(const LAS u32x4*)(tile + n2 * 72 + kc * 8);
        *(u32x4*)(dst + (size_t)(nt * 256 + n2) * K + kt * 64 + kc * 8) = w; }
    __syncthreads();
}
struct WDesc { const float* src; bf16_t* dst; const float* ksc; int K, Nsrc, Ndst, type; };
__device__ __forceinline__ void conv_item(LAS unsigned char* lds, const WDesc& w, int it) { const int nkt = w.K / 64; conv_tile(lds, w.src, w.Nsrc, w.dst, w.K, w.type, w.ksc, it % nkt, it / nkt); }
__device__ __forceinline__ int wtiles(const WDesc& w) { return (w.K / 64) * (w.Ndst / 256); }

__device__ __forceinline__ void ada_item(LAS unsigned char* lds, const Params& p, int item) {
    LAS float* sc = (LAS float*)lds;
    LAS float* red = (LAS float*)(lds + 65536);
    int tid = threadIdx.x; asm volatile("" : "+v"(tid));
    const int l = item / 96, col0 = (item % 96) * 128, cg4 = (tid & 31) * 4, ks = tid >> 5;
    for (int i = tid; i < NB * D; i += NTHR) sc[i] = siluf_(p.c[i]);
    __syncthreads();
    float acc[8][4];
#pragma unroll
    for (int b = 0; b < 8; ++b)
#pragma unroll
        for (int j = 0; j < 4; ++j) acc[b][j] = 0.f;
    const float* wp = p.w_ada + (size_t)l * D * 6 * D + (size_t)(ks * 128) * 6 * D + col0 + cg4;
#pragma unroll 16
    for (int k = 0; k < 128; ++k) { const f32x4 w = *(const f32x4*)(wp + (size_t)k * 6 * D);
#pragma unroll
        for (int b = 0; b < 8; ++b) { const float s = sc[b * D + ks * 128 + k];
#pragma unroll
            for (int j = 0; j < 4; ++j) acc[b][j] += s * w[j]; } }
#pragma unroll
    for (int b = 0; b < 8; ++b) *(LAS f32x4*)(red + (ks * 8 + b) * 128 + cg4) = (f32x4){acc[b][0], acc[b][1], acc[b][2], acc[b][3]};
    __syncthreads();
    for (int o = tid; o < 8 * 128; o += NTHR) { const int b = o >> 7, cc = o & 127; float s = 0.f;
#pragma unroll
        for (int k2 = 0; k2 < 16; ++k2) s += red[(k2 * 8 + b) * 128 + cc];
        float* mod = (float*)(p.ws + WS_MOD);
        mod[((size_t)l * NB + b) * 6 * D + col0 + cc] = s + p.b_ada[(size_t)l * 6 * D + col0 + cc]; }
    __syncthreads();
}
__device__ __forceinline__ void rope_item(const Params& p, int item) {
    float* COS = (float*)(p.ws + WS_COS); float* SIN = (float*)(p.ws + WS_SIN);
    int tid = threadIdx.x; asm volatile("" : "+v"(tid));
#pragma unroll
    for (int e = 0; e < 8; ++e) { const int idx = item * 4096 + e * NTHR + tid; const int t = idx >> 5, i = idx & 31;
        const float ang = (float)p.pos[t] * c_inv_freq[i];
        const double a = (double)ang; const double k = rint(a * 0.15915494309189535); const float r = (float)(a - k * 6.283185307179586);
        COS[idx] = __cosf(r); SIN[idx] = __sinf(r); }
}

template <bool FINAL, bool SRC16 = false>
__device__ __forceinline__ void norm_rows(const float* __restrict__ xin, const bf16_t* __restrict__ xin16, const float* __restrict__ w, const float* __restrict__ modl, int sh_k, int sc_k, bf16_t* __restrict__ dst, float* __restrict__ fout) {
    int tid = threadIdx.x; asm volatile("" : "+v"(tid));
    const int lane = tid & 63, gw = blockIdx.x * 8 + (tid >> 6), nw = gridDim.x * 8;
    for (int row = gw; row < T; row += nw) {
        const int b = row / SEQ;
        if (SRC16) {
            f32x4 v[4][2]; float s = 0.f;
#pragma unroll
            for (int i = 0; i < 4; ++i) { const u32x4 r4 = *(const u32x4*)(xin16 + (size_t)row * D + (i * 64 + lane) * 8);
                v[i][0] = (f32x4){bflo(r4[0]), bfhi(r4[0]), bflo(r4[1]), bfhi(r4[1])}; v[i][1] = (f32x4){bflo(r4[2]), bfhi(r4[2]), bflo(r4[3]), bfhi(r4[3])};
#pragma unroll
                for (int hh = 0; hh < 2; ++hh) s += (v[i][hh][0] * v[i][hh][0] + v[i][hh][1] * v[i][hh][1]) + (v[i][hh][2] * v[i][hh][2] + v[i][hh][3] * v[i][hh][3]); }
            s = wave_sum(s);
            const float rs = rsqrtf(s * (1.0f / D) + EPS);
#pragma unroll
            for (int i = 0; i < 4; ++i) { const int c = (i * 64 + lane) * 8; f32x4 o[2];
#pragma unroll
                for (int hh = 0; hh < 2; ++hh) { const f32x4 ww = *(const f32x4*)(w + c + 4 * hh);
                    if (FINAL) o[hh] = v[i][hh] * rs * ww;
                    else { const f32x4 sh = *(const f32x4*)(modl + (size_t)b * 6 * D + sh_k * D + c + 4 * hh), sc = *(const f32x4*)(modl + (size_t)b * 6 * D + sc_k * D + c + 4 * hh);
                        o[hh] = v[i][hh] * rs * ww * (sc + 1.0f) + sh; } }
                if (FINAL) { *(f32x4*)(fout + (size_t)row * D + c) = o[0]; *(f32x4*)(fout + (size_t)row * D + c + 4) = o[1]; }
                else *(u32x4*)(dst + (size_t)row * D + c) = pack8u(o[0], o[1]); }
        } else {
            f32x4 v[4][2]; float s = 0.f;
#pragma unroll
            for (int i = 0; i < 4; ++i)
#pragma unroll
                for (int hh = 0; hh < 2; ++hh) { v[i][hh] = *(const f32x4*)(xin + (size_t)row * D + (i * 64 + lane) * 8 + 4 * hh);
                    s += (v[i][hh][0] * v[i][hh][0] + v[i][hh][1] * v[i][hh][1]) + (v[i][hh][2] * v[i][hh][2] + v[i][hh][3] * v[i][hh][3]); }
            s = wave_sum(s);
            const float rs = rsqrtf(s * (1.0f / D) + EPS);
#pragma unroll
            for (int i = 0; i < 4; ++i) { const int c = (i * 64 + lane) * 8; f32x4 o[2];
#pragma unroll
                for (int hh = 0; hh < 2; ++hh) { const f32x4 ww = *(const f32x4*)(w + c + 4 * hh);
                    if (FINAL) o[hh] = v[i][hh] * rs * ww;
                    else { const f32x4 sh = *(const f32x4*)(modl + (size_t)b * 6 * D + sh_k * D + c + 4 * hh), sc = *(const f32x4*)(modl + (size_t)b * 6 * D + sc_k * D + c + 4 * hh);
                        o[hh] = v[i][hh] * rs * ww * (sc + 1.0f) + sh; } }
                if (FINAL) { *(f32x4*)(fout + (size_t)row * D + c) = o[0]; *(f32x4*)(fout + (size_t)row * D + c + 4) = o[1]; }
                else *(u32x4*)(dst + (size_t)row * D + c) = pack8u(o[0], o[1]); }
        }
    }
}
#define LDS_BAR() do { asm volatile("s_waitcnt lgkmcnt(0)" ::: "memory"); __builtin_amdgcn_s_barrier(); asm volatile("" ::: "memory"); } while (0)
namespace att {
constexpr int KVBLK = 64, QB = 256, SHM_V = KVBLK * 128 * 2, SHM_K = KVBLK * DQK * 2;
constexpr int OFF_V = 0, OFF_K = 3 * SHM_V, OFF_W = OFF_K + 3 * SHM_K;
static_assert(OFF_W + 2048 <= MISC_OFF, "attention LDS");
__device__ __forceinline__ int v_st(int k, int c) { const int kk = (k & ~0xC) | ((k & 4) << 1) | ((k & 8) >> 1); return ((kk >> 3) * 4 + (c >> 5)) * 512 + ((kk & 7) * 32 + (c & 31)) * 2; }
__device__ __forceinline__ int v_rd_base(int lane) { return ((lane & 3) << 3) | (((lane >> 2) & 3) << 6) | (((lane >> 4) & 1) << 5) | (((lane >> 5) & 1) << 8); }
constexpr int v_rd_off(int d0, int ks, int half) { return d0 * 512 + ks * 4096 + half * 2048; }
#define ATT_SBAR() __builtin_amdgcn_sched_barrier(0)
constexpr float THR = 8.f;
__device__ __forceinline__ void partialSM(f32x16& p0, f32x16& p1, float& m_reg, float& alpha) {
    float pmax = p0[0];
#pragma unroll
    for (int r = 1; r < 16; ++r) pmax = fmaxf(pmax, p0[r]);
#pragma unroll
    for (int r = 0; r < 16; ++r) pmax = fmaxf(pmax, p1[r]);
    { auto rr = __builtin_amdgcn_permlane32_swap(__float_as_uint(pmax), __float_as_uint(pmax), false, false);
      pmax = fmaxf(__uint_as_float(rr[0]), __uint_as_float(rr[1])); }
    float mn;
    if (__all((pmax - m_reg) <= THR)) { mn = m_reg; alpha = 1.f; }
    else { mn = fmaxf(m_reg, pmax); alpha = __builtin_amdgcn_exp2f(m_reg - mn); m_reg = mn; }
#pragma unroll
    for (int r = 0; r < 16; ++r) { p0[r] = __builtin_amdgcn_exp2f(p0[r] - mn); p1[r] = __builtin_amdgcn_exp2f(p1[r] - mn); }
}
__device__ __forceinline__ void finishSM(const f32x16& p0, const f32x16& p1, float alpha, float& l_reg, bf16x8& pa0, bf16x8& pa1, bf16x8& pa2, bf16x8& pa3) {
    float ps = 0;
#pragma unroll
    for (int r = 0; r < 16; ++r) ps += p0[r];
#pragma unroll
    for (int r = 0; r < 16; ++r) ps += p1[r];
    { auto rr = __builtin_amdgcn_permlane32_swap(__float_as_uint(ps), __float_as_uint(ps), false, false);
      ps = __uint_as_float(rr[0]) + __uint_as_float(rr[1]); }
    l_reg = l_reg * alpha + ps;
#define PK4(P, B_, OUT) do { unsigned a0 = cvt_pk_bf16(P[B_+0], P[B_+1]), a1 = cvt_pk_bf16(P[B_+2], P[B_+3]);                          \
        unsigned b0 = cvt_pk_bf16(P[B_+4], P[B_+5]), b1 = cvt_pk_bf16(P[B_+6], P[B_+7]);                                             \
        auto r0 = __builtin_amdgcn_permlane32_swap(a0, b0, false, false); auto r1 = __builtin_amdgcn_permlane32_swap(a1, b1, false, false); \
        u32x4 w = {r0[0], r1[0], r0[1], r1[1]}; OUT = *reinterpret_cast<bf16x8*>(&w); } while (0)
    PK4(p0, 0, pa0); PK4(p0, 8, pa1); PK4(p1, 0, pa2); PK4(p1, 8, pa3);
#undef PK4
}
template <int KB>
__device__ __forceinline__ void qkt(f32x16& p0, f32x16& p1, const LAS char* K_lds, int r32, int hi, const bf16x8* qr) {
    p0 = f32x16{}; p1 = f32x16{};
    const LAS char* kb[4];
#pragma unroll
    for (int dd = 0; dd < 4; ++dd) kb[dd] = K_lds + KB * SHM_K + r32 * 384 + (((2 * dd + hi) ^ (r32 & 7)) << 4);
#pragma unroll
    for (int d0 = 0; d0 < 12; ++d0) { const LAS char* a = kb[d0 & 3] + (d0 >> 2) * 128;
        bf16x8 b0 = *(const LAS bf16x8*)(a);
        bf16x8 b1 = *(const LAS bf16x8*)(a + 32 * 384);
        p0 = __builtin_amdgcn_mfma_f32_32x32x16_bf16(b0, qr[d0], p0, 0, 0, 0);
        p1 = __builtin_amdgcn_mfma_f32_32x32x16_bf16(b1, qr[d0], p1, 0, 0, 0); }
}
template <int VB>
__device__ __forceinline__ void pv_tile(f32x16* o, int vb0, bf16x8 pa0, bf16x8 pa1, bf16x8 pa2, bf16x8 pa3) {
#define TRRD(dst, off) asm volatile("ds_read_b64_tr_b16 %0, %1 offset:%2" : "=&v"(dst) : "v"(vb0), "i"(off) : "memory")
#define PV_D0(d0) do { s16x4 l0, l1, l2, l3, h0, h1, h2, h3; constexpr int b_ = VB * SHM_V + v_rd_off(d0, 0, 0); \
        TRRD(l0, b_); TRRD(h0, b_ + 2048); TRRD(l1, b_ + 4096); TRRD(h1, b_ + 6144); TRRD(l2, b_ + 8192); TRRD(h2, b_ + 10240); TRRD(l3, b_ + 12288); TRRD(h3, b_ + 14336); \
        asm volatile("s_waitcnt lgkmcnt(0)" ::: "memory"); ATT_SBAR();   \
        o[d0] = __builtin_amdgcn_mfma_f32_32x32x16_bf16(pa0, (bf16x8){l0[0], l0[1], l0[2], l0[3], h0[0], h0[1], h0[2], h0[3]}, o[d0], 0, 0, 0);   \
        o[d0] = __builtin_amdgcn_mfma_f32_32x32x16_bf16(pa1, (bf16x8){l1[0], l1[1], l1[2], l1[3], h1[0], h1[1], h1[2], h1[3]}, o[d0], 0, 0, 0);   \
        o[d0] = __builtin_amdgcn_mfma_f32_32x32x16_bf16(pa2, (bf16x8){l2[0], l2[1], l2[2], l2[3], h2[0], h2[1], h2[2], h2[3]}, o[d0], 0, 0, 0);   \
        o[d0] = __builtin_amdgcn_mfma_f32_32x32x16_bf16(pa3, (bf16x8){l3[0], l3[1], l3[2], l3[3], h3[0], h3[1], h3[2], h3[3]}, o[d0], 0, 0, 0); } while (0)
    PV_D0(0); PV_D0(1); PV_D0(2); PV_D0(3);
#undef PV_D0
#undef TRRD
}
__device__ __forceinline__ void attn_unit(LAS unsigned char* lds, const bf16_t* __restrict__ Q, const bf16_t* __restrict__ Kg, const bf16_t* __restrict__ Vg, bf16_t* __restrict__ AO, int b, int h, int qb) {
    int tid = threadIdx.x; asm volatile("" : "+v"(tid));
    const int wid = __builtin_amdgcn_readfirstlane(tid >> 6), lane = tid & 63, r32 = lane & 31, hi = lane >> 5;
    const int P0 = qb * QB, NT = 4 * (qb + 1), qlo = P0 + wid * 32;
    const bf16_t* Qp = Q + (size_t)(b * NH + h) * SEQ * DQK; const bf16_t* Kp = Kg + (size_t)(b * NH + h) * SEQ * DQK; const bf16_t* Vp = Vg + (size_t)(b * NH + h) * SEQ * 128;
    const LAS char* K_lds = (const LAS char*)lds + OFF_K;
    LAS float* ws = (LAS float*)(lds + OFF_W) + wid * 64; LAS float* li_l = ws; LAS float* al_l = ws + 32;
    bf16x8 qr[12];
#pragma unroll
    for (int d0 = 0; d0 < 12; ++d0) qr[d0] = *(const bf16x8*)(Qp + (size_t)(qlo + r32) * DQK + d0 * 16 + hi * 8);
    int vso0;
    { const int o = tid * 16, sub = o >> 9, rem = (o & 511) >> 1; const int kk = (sub >> 2) * 8 + (rem >> 5), c = (sub & 3) * 32 + (rem & 31);
      const int k = (kk & ~0xC) | ((kk & 4) << 1) | ((kk & 8) >> 1); vso0 = k * 128 + c; }
#define ATT_LOAD(t_, bf_) do { const bf16_t* kk_ = Kp + (size_t)(t_) * KVBLK * DQK; const bf16_t* vv_ = Vp + (size_t)(t_) * KVBLK * 128; int tt_ = tid; asm volatile("" : "+v"(tt_)); \
        _Pragma("unroll") for (int i = 0; i < 3; ++i) { const int id = tt_ + i * NTHR, row = id / 24, cc = id % 24; \
            __builtin_amdgcn_global_load_lds((const unsigned*)(kk_ + row * DQK + ((cc ^ (row & 7)) << 3)), (LAS unsigned*)(lds + OFF_K + (bf_) * SHM_K + (i * NTHR + wid * 64) * 16), 16, 0, 0); } \
        _Pragma("unroll") for (int i = 0; i < 2; ++i) __builtin_amdgcn_global_load_lds((const unsigned*)(vv_ + vso0 + i * 32 * 128), (LAS unsigned*)(lds + OFF_V + (bf_) * SHM_V + (i * NTHR + wid * 64) * 16), 16, 0, 0); } while (0)
    ATT_LOAD(0, 0);
    if (NT > 1) { ATT_LOAD(1, 1); asm volatile("s_waitcnt vmcnt(5)" ::: "memory"); } else { asm volatile("s_waitcnt vmcnt(0)" ::: "memory"); }
    LDS_BAR();
    float m_reg = -1e30f, l_reg = 0.f; f32x16 o[4] = {};
    const int vb0 = (int)(unsigned)(uintptr_t)(lds + OFF_V) + v_rd_base(lane);
#define ATT_STEP(BI) do { \
        if (kb <= qlo + 31) {                                                 \
            f32x16 p0, p1; float alpha; bf16x8 pa0, pa1, pa2, pa3; \
            qkt<BI>(p0, p1, K_lds, r32, hi, qr); \
            if (kb + KVBLK - 1 > qlo) {                                       \
                const int dq = qlo + r32 - kb - 4 * hi; const float NEG = -__builtin_inff(); \
                _Pragma("unroll") for (int r = 0; r < 16; ++r) { const int c = (r & 3) + 8 * (r >> 2); if (dq - c < 0) p0[r] = NEG; if (dq - c - 32 < 0) p1[r] = NEG; } \
            } \
            partialSM(p0, p1, m_reg, alpha); \
            if (__any(alpha < 1.f)) { if (hi == 0) al_l[r32] = alpha; asm volatile("s_waitcnt lgkmcnt(0)" ::: "memory"); \
                _Pragma("unroll") for (int d_ = 0; d_ < 4; ++d_) _Pragma("unroll") for (int r = 0; r < 16; ++r) o[d_][r] *= al_l[crow(r, hi)]; } \
            finishSM(p0, p1, alpha, l_reg, pa0, pa1, pa2, pa3); ATT_SBAR(); \
            pv_tile<BI>(o, vb0, pa0, pa1, pa2, pa3); \
        } } while (0)
    int bi = 0;
#pragma unroll 1
    for (int t = 0; t < NT; ++t) {
        const int kb = t * KVBLK;
        if (t + 2 < NT) { if (bi == 0) ATT_LOAD(t + 2, 2); else if (bi == 1) ATT_LOAD(t + 2, 0); else ATT_LOAD(t + 2, 1); }
        if (bi == 0) ATT_STEP(0); else if (bi == 1) ATT_STEP(1); else ATT_STEP(2);
        if (t + 2 < NT) asm volatile("s_waitcnt vmcnt(5)" ::: "memory"); else asm volatile("s_waitcnt vmcnt(0)" ::: "memory");
        LDS_BAR();
        bi = (bi == 2) ? 0 : bi + 1;
    }
#undef ATT_STEP
    if (hi == 0) li_l[r32] = l_reg; asm volatile("s_waitcnt lgkmcnt(0)" ::: "memory");
    bf16_t* Ow = AO + ((size_t)b * SEQ + qlo) * 1024 + h * 128;
#pragma unroll
    for (int r = 0; r < 16; ++r) { const int orow = crow(r, hi); const float rl = __builtin_amdgcn_rcpf(li_l[orow]);
#pragma unroll
        for (int d0 = 0; d0 < 4; ++d0) { const float v = o[d0][r] * rl; const float vn = swz<1>(v);
            if ((r32 & 1) == 0) *(unsigned*)(Ow + (size_t)orow * 1024 + d0 * 32 + r32) = cvt_pk_bf16(v, vn); } }
    __syncthreads();
#undef ATT_LOAD
}
}

namespace gdn {
constexpr int XS = 132;
constexpr int OFF_XQ = 0, OFF_XK = 64 * XS * 4, OFF_XV = 2 * 64 * XS * 4, OFF_LM = 3 * 64 * XS * 4, OFF_BETA = OFF_LM + 64 * 64 * 4, OFF_G = OFF_BETA + 256, OFF_EG = OFF_G + 256, OFF_TI = OFF_EG + 256;
__device__ __forceinline__ void prep_unit(LAS unsigned char* lds, const Params& p, int l, int unit) {
    int tid = threadIdx.x; asm volatile("" : "+v"(tid));
    const int wid = tid >> 6, lane = tid & 63;
    const int b = unit / (NH * NCH), h = (unit / NCH) % NH, n = unit % NCH;
    const int row0 = b * SEQ + n * CHK;
    LAS float* Xq = (LAS float*)(lds + OFF_XQ); LAS float* Xk = (LAS float*)(lds + OFF_XK); LAS float* Xv = (LAS float*)(lds + OFF_XV);
    LAS float* Lm = (LAS float*)(lds + OFF_LM); LAS float* beta = (LAS float*)(lds + OFF_BETA); LAS float* Gc = (LAS float*)(lds + OFF_G); LAS float* eG = (LAS float*)(lds + OFF_EG);
    const bf16_t* QKVG = (const bf16_t*)(p.ws + AR_QKVG); const float* BA = (const float*)(p.ws + WS_BA);
    float* U = (float*)(p.ws + WS_H); bf16_t* Wg = (bf16_t*)(p.ws + AR_WG); bf16_t* QG = (bf16_t*)(p.ws + AR_QG); bf16_t* KDT = (bf16_t*)(p.ws + AR_KDT); bf16_t* ATT = (bf16_t*)(p.ws + AR_ATT);
    float* EGL = (float*)(p.ws + WS_EGL);
#ifndef NO_CONV
    for (int rpc = 0; rpc < (PROBE_SEL == 7 ? 2 : 1); ++rpc)
    if (tid < 384) {
        const int cgp = tid % 48, rg = tid / 48, mat = cgp / 16, c8 = (cgp % 16) * 8, col = mat * 1024 + h * 128 + c8;
        float wj[4][8];
#pragma unroll
        for (int j = 0; j < 4; ++j) { const float* wp = p.conv_w + ((size_t)l * 4 + j) * 3072 + col; const f32x4 a = *(const f32x4*)wp, c = *(const f32x4*)(wp + 4);
            wj[j][0] = a[0]; wj[j][1] = a[1]; wj[j][2] = a[2]; wj[j][3] = a[3]; wj[j][4] = c[0]; wj[j][5] = c[1]; wj[j][6] = c[2]; wj[j][7] = c[3]; }
        float u[11][8];
#pragma unroll
        for (int k = 0; k < 11; ++k) { const int tt = n * CHK + rg * 8 - 3 + k;
            u32x4 w = {0u, 0u, 0u, 0u};
            if (tt >= 0) w = *(const u32x4*)(QKVG + (size_t)(b * SEQ + tt) * 3072 + col);
            u[k][0] = bflo(w[0]); u[k][1] = bfhi(w[0]); u[k][2] = bflo(w[1]); u[k][3] = bfhi(w[1]); u[k][4] = bflo(w[2]); u[k][5] = bfhi(w[2]); u[k][6] = bflo(w[3]); u[k][7] = bfhi(w[3]); }
        LAS float* X = (mat == 0) ? Xq : (mat == 1 ? Xk : Xv);
#pragma unroll
        for (int i = 0; i < 8; ++i) { f32x4 y0, y1;
#pragma unroll
            for (int c = 0; c < 8; ++c) { float y = wj[0][c] * u[i][c] + wj[1][c] * u[i + 1][c] + wj[2][c] * u[i + 2][c] + wj[3][c] * u[i + 3][c]; y = siluf_(y); if (c < 4) y0[c] = y; else y1[c - 4] = y; }
            *(LAS f32x4*)(X + (rg * 8 + i) * XS + c8) = y0; *(LAS f32x4*)(X + (rg * 8 + i) * XS + c8 + 4) = y1; }
    }
#endif
    LDS_BAR();
#pragma unroll
    for (int mat = 0; mat < 2; ++mat) { LAS float* X = (mat ? Xk : Xq) + (tid >> 3) * XS + (tid & 7) * 16;
        f32x4 v[4]; float s = 0.f;
#pragma unroll
        for (int j = 0; j < 4; ++j) { v[j] = *(const LAS f32x4*)(X + 4 * j); s += (v[j][0] * v[j][0] + v[j][1] * v[j][1]) + (v[j][2] * v[j][2] + v[j][3] * v[j][3]); }
        s += swz<1>(s); s += swz<2>(s); s += swz<4>(s);
        const float sc = rsqrtf(s + EPS) * (mat ? 1.0f : 0.08838834764831845f);
#pragma unroll
        for (int j = 0; j < 4; ++j) *(LAS f32x4*)(X + 4 * j) = v[j] * sc; }
    if (wid == 0) {
        const float bl = BA[(size_t)(row0 + lane) * 16 + h], al = BA[(size_t)(row0 + lane) * 16 + 8 + h];
        const float xx = al + p.dt_bias[l * NH + h];
        const float sp = fmaxf(xx, 0.f) + log1pf(__expf(-fabsf(xx)));
        const float g0 = -__expf(p.A_log[l * NH + h]) * sp;
        Gc[lane] = g0; asm volatile("s_waitcnt lgkmcnt(0)" ::: "memory");
        float g = 0.f;
#pragma unroll 8
        for (int j = 0; j < 64; ++j) { const float gj = Gc[j]; g += (j <= lane) ? gj : 0.f; }
        asm volatile("s_waitcnt lgkmcnt(0)" ::: "memory");
        beta[lane] = sigmoidf_(bl); eG[lane] = __expf(g); Gc[lane] = g;
        if (lane == 63) EGL[unit] = __expf(g);
    }
    LDS_BAR();
    for (int rp3 = 0; rp3 < (PROBE_SEL == 8 ? 2 : 1); ++rp3)
#pragma unroll 1
    for (int tt = 0; tt < 2; ++tt) { const int ti = wid * 2 + tt, it = ti >> 2, jt = ti & 3;
        f32x4 aKK = {0.f, 0.f, 0.f, 0.f}, aQK = {0.f, 0.f, 0.f, 0.f};
        if (jt <= it) {
            const LAS float* pk = Xk + (16 * it + (lane & 15)) * XS + (lane >> 4); const LAS float* pq = Xq + (16 * it + (lane & 15)) * XS + (lane >> 4);
            const LAS float* pb = Xk + (16 * jt + (lane & 15)) * XS + (lane >> 4);
#pragma unroll 8
            for (int d = 0; d < 128; d += 4) { const float ak = pk[d], aq = pq[d], bk = pb[d];
                aKK = __builtin_amdgcn_mfma_f32_16x16x4f32(ak, bk, aKK, 0, 0, 0); aQK = __builtin_amdgcn_mfma_f32_16x16x4f32(aq, bk, aQK, 0, 0, 0); }
        }
#pragma unroll
        for (int r = 0; r < 4; ++r) { const int ig = 16 * it + 4 * (lane >> 4) + r, jg = 16 * jt + (lane & 15);
            const float dec = (ig >= jg) ? __expf(Gc[ig] - Gc[jg]) : 0.f;
            Lm[ig * 64 + jg] = (ig > jg) ? beta[ig] * aKK[r] * dec : 0.f;
            ATT[(size_t)unit * 4096 + ig * 64 + jg] = f2bf(aQK[r] * dec); }
    }
    LDS_BAR();
    for (int rp4 = 0; rp4 < (PROBE_SEL == 9 ? 2 : 1); ++rp4)
    { const float Gl = Gc[63];
#pragma unroll
        for (int e = 0; e < 2; ++e) { const int idx = tid + NTHR * e, r = idx >> 4, c8 = (idx & 15) * 8; const float sc = eG[r];
            const f32x4 a = *(const LAS f32x4*)(Xq + r * XS + c8) * sc, c = *(const LAS f32x4*)(Xq + r * XS + c8 + 4) * sc;
            *(u32x4*)(QG + ((size_t)unit * 64 + r) * 128 + c8) = pack8u(a, c); }
#pragma unroll
        for (int e = 0; e < 2; ++e) { const int idx = tid + NTHR * e, dk = idx & 127, t8 = (idx >> 7) * 8; f32x4 a, c;
#pragma unroll
            for (int j = 0; j < 4; ++j) { a[j] = Xk[(t8 + j) * XS + dk] * __expf(Gl - Gc[t8 + j]); c[j] = Xk[(t8 + 4 + j) * XS + dk] * __expf(Gl - Gc[t8 + 4 + j]); }
            *(u32x4*)(KDT + ((size_t)unit * 128 + dk) * 64 + t8) = pack8u(a, c); } }
    LDS_BAR();
#pragma unroll
    for (int e = 0; e < 4; ++e) { const int idx = tid + NTHR * e, r = idx >> 5, c4 = (idx & 31) * 4; const float bt = beta[r], bw = bt * eG[r];
        *(LAS f32x4*)(Xv + r * XS + c4) = *(const LAS f32x4*)(Xv + r * XS + c4) * bt;
        *(LAS f32x4*)(Xq + r * XS + c4) = *(const LAS f32x4*)(Xk + r * XS + c4) * bw; }
    LAS float* TI = (LAS float*)(lds + OFF_TI);
    if (tid < 64) { const int Ib = tid >> 4, j = tid & 15; const LAS float* Lb = Lm + (16 * Ib) * 64 + 16 * Ib;
        float tv[16];
#pragma unroll
        for (int r = 0; r < 16; ++r) { float sacc = (r == j) ? 1.0f : 0.0f;
#pragma unroll
            for (int c4 = 0; c4 < (r + 3) / 4; ++c4) { const f32x4 L4 = *(const LAS f32x4*)(Lb + r * 64 + 4 * c4);
#pragma unroll
                for (int e = 0; e < 4; ++e) if (4 * c4 + e < r) sacc -= L4[e] * tv[4 * c4 + e]; }
            tv[r] = sacc; TI[(Ib * 16 + r) * 16 + j] = sacc; } }
    LDS_BAR();
    { LAS float* Xb0 = ((wid * 2) < 8 ? Xv : Xq) + ((wid * 2) & 7) * 16; LAS float* Xb1 = ((wid * 2 + 1) < 8 ? Xv : Xq) + ((wid * 2 + 1) & 7) * 16;
      const int li = lane & 15, lq = lane >> 4;
#pragma unroll 1
      for (int I = 0; I < 4; ++I) {
          f32x4 a0 = {0.f, 0.f, 0.f, 0.f}, a1 = {0.f, 0.f, 0.f, 0.f};
          const LAS float* pa = Lm + (16 * I + li) * 64 + lq;
#pragma unroll 4
          for (int kk = 0; kk < 16 * I; kk += 4) { const float av = pa[kk];
              a0 = __builtin_amdgcn_mfma_f32_16x16x4f32(av, Xb0[(kk + lq) * XS + li], a0, 0, 0, 0);
              a1 = __builtin_amdgcn_mfma_f32_16x16x4f32(av, Xb1[(kk + lq) * XS + li], a1, 0, 0, 0); }
#pragma unroll
          for (int r = 0; r < 4; ++r) { LAS float* x0 = Xb0 + (16 * I + 4 * lq + r) * XS + li; LAS float* x1 = Xb1 + (16 * I + 4 * lq + r) * XS + li; *x0 -= a0[r]; *x1 -= a1[r]; }
          asm volatile("s_waitcnt lgkmcnt(0)" ::: "memory");
          f32x4 y0 = {0.f, 0.f, 0.f, 0.f}, y1 = {0.f, 0.f, 0.f, 0.f};
          const LAS float* pt = TI + (I * 16 + li) * 16 + lq;
#pragma unroll
          for (int sx = 0; sx < 4; ++sx) { const float tvv = pt[4 * sx];
              y0 = __builtin_amdgcn_mfma_f32_16x16x4f32(tvv, Xb0[(16 * I + 4 * sx + lq) * XS + li], y0, 0, 0, 0);
              y1 = __builtin_amdgcn_mfma_f32_16x16x4f32(tvv, Xb1[(16 * I + 4 * sx + lq) * XS + li], y1, 0, 0, 0); }
#pragma unroll
          for (int r = 0; r < 4; ++r) { Xb0[(16 * I + 4 * lq + r) * XS + li] = y0[r]; Xb1[(16 * I + 4 * lq + r) * XS + li] = y1[r]; }
          asm volatile("s_waitcnt lgkmcnt(0)" ::: "memory");
      } }
    LDS_BAR();
#pragma unroll
    for (int e = 0; e < 4; ++e) { const int idx = tid + NTHR * e, r = idx >> 5, c4 = (idx & 31) * 4;
        *(f32x4*)(U + ((size_t)unit * 64 + r) * 128 + c4) = *(const LAS f32x4*)(Xv + r * XS + c4);
        *(u32x2*)(Wg + ((size_t)unit * 64 + r) * 128 + c4) = pack4u(*(const LAS f32x4*)(Xq + r * XS + c4)); }
    LDS_BAR();
}

constexpr int SS = 136, VS = 72, OS = 132;
constexpr int OFF_ST = 0, OFF_VT = 128 * SS * 2, OFF_OT = OFF_VT + 128 * VS * 2, OFF_WQ = OFF_OT + 64 * OS * 4;
static_assert(OFF_WQ + 65536 <= MISC_OFF, "scan LDS");
__device__ __forceinline__ void scan_unit(LAS unsigned char* lds, const Params& p, int l, int bh) {
    int tid = threadIdx.x; asm volatile("" : "+v"(tid));
    const int wid = __builtin_amdgcn_readfirstlane(tid >> 6), lane = tid & 63, r32 = lane & 31, hi = lane >> 5;
    const int tm = wid & 1, tn = wid >> 1, b = bh / NH, h = bh % NH;
    LAS bf16_t* St = (LAS bf16_t*)(lds + OFF_ST); LAS bf16_t* Vt = (LAS bf16_t*)(lds + OFF_VT); LAS float* Ot = (LAS float*)(lds + OFF_OT);
    const float* U = (const float*)(p.ws + WS_H); const bf16_t* Wg = (const bf16_t*)(p.ws + AR_WG); const bf16_t* QG = (const bf16_t*)(p.ws + AR_QG);
    const bf16_t* KDT = (const bf16_t*)(p.ws + AR_KDT); const bf16_t* ATT = (const bf16_t*)(p.ws + AR_ATT); const float* EGL = (const float*)(p.ws + WS_EGL);
    const bf16_t* Z = (const bf16_t*)(p.ws + AR_Z); bf16_t* GO = (bf16_t*)(p.ws + AR_GO);
    f32x16 S0 = {}, S1 = {};
    for (int i = tid; i < 128 * SS / 2; i += NTHR) ((LAS unsigned*)St)[i] = 0u;
    LDS_BAR();
    const int gseg = tid & 7, gtok = tid >> 3;
    bf16x8 aa[4], ka[4], kb[4]; float uu[16]; u32x4 z0, z1;
    int dsrc[2];
#pragma unroll
    for (int i = 0; i < 2; ++i) { const int id = tid + i * NTHR, row = id >> 4, cc = id & 15; dsrc[i] = row * 128 + ((cc ^ (row & 7)) << 3); }
#define SCAN_DMA(cu_, bf_) do { const bf16_t* wsrc_ = Wg + (cu_) * 8192; const bf16_t* qsrc_ = QG + (cu_) * 8192; \
        _Pragma("unroll") for (int i = 0; i < 2; ++i) { \
            __builtin_amdgcn_global_load_lds((const unsigned*)(wsrc_ + dsrc[i]), (LAS unsigned*)(lds + OFF_WQ + (bf_) * 32768 + (i * NTHR + wid * 64) * 16), 16, 0, 0); \
            __builtin_amdgcn_global_load_lds((const unsigned*)(qsrc_ + dsrc[i]), (LAS unsigned*)(lds + OFF_WQ + (bf_) * 32768 + 16384 + (i * NTHR + wid * 64) * 16), 16, 0, 0); } } while (0)
#define SCAN_LD_U(cu_) do { const float* up = U + ((cu_) * 64 + 32 * tm) * 128 + 32 * tn + r32; _Pragma("unroll") for (int r = 0; r < 16; ++r) uu[r] = up[(size_t)crow(r, hi) * 128]; } while (0)
#define SCAN_LD_AA(cu_) do { const bf16_t* ap = ATT + ((cu_) * 64 + 32 * tm + r32) * 64 + 8 * hi; \
        _Pragma("unroll") for (int ks = 0; ks < 4; ++ks) aa[ks] = *(const bf16x8*)(ap + 16 * ks); } while (0)
#define SCAN_LD_K(cu_) do { const bf16_t* k0 = KDT + ((cu_) * 128 + 64 * tm + r32) * 64 + 8 * hi; \
        _Pragma("unroll") for (int ks = 0; ks < 4; ++ks) { ka[ks] = *(const bf16x8*)(k0 + 16 * ks); kb[ks] = *(const bf16x8*)(k0 + 32 * 64 + 16 * ks); } } while (0)
#define SCAN_LD_Z(n_) do { const size_t go_ = ((size_t)b * SEQ + (n_) * CHK + gtok) * 1024 + h * 128 + gseg * 16; z0 = *(const u32x4*)(Z + go_); z1 = *(const u32x4*)(Z + go_ + 8); } while (0)
    LAS float* Gn = (LAS float*)(lds + OFF_WQ + 65536);
    if (tid < 128) Gn[tid] = p.gdn_norm[l * 128 + tid];
    { const size_t cu0 = (size_t)bh * NCH; SCAN_DMA(cu0, 0); SCAN_DMA(cu0 + 1, 1); SCAN_LD_U(cu0); SCAN_LD_K(cu0); SCAN_LD_Z(0); }
    asm volatile("s_waitcnt vmcnt(0)" ::: "memory");
    LDS_BAR();
    const int arow = (32 * tm + r32) * 256;
    int abase[4];
#pragma unroll
    for (int dd = 0; dd < 4; ++dd) abase[dd] = arow + (((2 * dd + hi) ^ (r32 & 7)) << 4);
#pragma unroll 1
    for (int n = 0; n < NCH; ++n) {
        const size_t cu = (size_t)bh * NCH + n;
        const int n1 = (n + 1 < NCH) ? n + 1 : NCH - 1, n2 = (n + 2 < NCH) ? n + 2 : NCH - 1;
        const size_t cu1 = (size_t)bh * NCH + n1, cu2 = (size_t)bh * NCH + n2;
        const float egl = EGL[cu];
        SCAN_LD_AA(cu);
        f32x16 aW = {}, aQ = {};
        { const LAS bf16_t* sp = St + (32 * tn + r32) * SS + 8 * hi; const LAS unsigned char* wq = lds + OFF_WQ + (n & 1) * 32768;
#pragma unroll
          for (int ks = 0; ks < 8; ++ks) { const bf16x8 sb = *(const LAS bf16x8*)(sp + 16 * ks);
              const bf16x8 wa = *(const LAS bf16x8*)(wq + abase[ks & 3] + (ks >> 2) * 128), qa = *(const LAS bf16x8*)(wq + 16384 + abase[ks & 3] + (ks >> 2) * 128);
              aW = __builtin_amdgcn_mfma_f32_32x32x16_bf16(wa, sb, aW, 0, 0, 0); aQ = __builtin_amdgcn_mfma_f32_32x32x16_bf16(qa, sb, aQ, 0, 0, 0); } }
#pragma unroll
        for (int r4 = 0; r4 < 4; ++r4) { f32x4 vn;
#pragma unroll
            for (int j = 0; j < 4; ++j) { const int r = 4 * r4 + j; vn[j] = uu[r] - aW[r]; }
            *(LAS u32x2*)(Vt + (32 * tn + r32) * VS + 32 * tm + 8 * r4 + 4 * hi) = pack4u(vn); }
        SCAN_LD_U(cu1);
        LDS_BAR();
        if (n & 1) SCAN_DMA(cu2, 1); else SCAN_DMA(cu2, 0);
        { const LAS bf16_t* vp = Vt + (32 * tn + r32) * VS + 8 * hi;
          S0 *= egl; S1 *= egl;
#pragma unroll
          for (int ks = 0; ks < 4; ++ks) { const bf16x8 vb = *(const LAS bf16x8*)(vp + 16 * ks);
              aQ = __builtin_amdgcn_mfma_f32_32x32x16_bf16(aa[ks], vb, aQ, 0, 0, 0);
              S0 = __builtin_amdgcn_mfma_f32_32x32x16_bf16(ka[ks], vb, S0, 0, 0, 0); S1 = __builtin_amdgcn_mfma_f32_32x32x16_bf16(kb[ks], vb, S1, 0, 0, 0); } }
        SCAN_LD_K(cu1);
#pragma unroll
        for (int r = 0; r < 16; ++r) Ot[(32 * tm + crow(r, hi)) * OS + 32 * tn + r32] = aQ[r];
#pragma unroll
        for (int r4 = 0; r4 < 4; ++r4) { const f32x4 a = {S0[4 * r4], S0[4 * r4 + 1], S0[4 * r4 + 2], S0[4 * r4 + 3]}, c = {S1[4 * r4], S1[4 * r4 + 1], S1[4 * r4 + 2], S1[4 * r4 + 3]};
            LAS bf16_t* sp = St + (32 * tn + r32) * SS + 64 * tm + 8 * r4 + 4 * hi;
            *(LAS u32x2*)sp = pack4u(a); *(LAS u32x2*)(sp + 32) = pack4u(c); }
        asm volatile("s_waitcnt vmcnt(28)" ::: "memory");
        LDS_BAR();
        { const LAS float* op = Ot + gtok * OS + gseg * 16; f32x4 ov[4]; float s = 0.f;
#pragma unroll
          for (int j = 0; j < 4; ++j) { ov[j] = *(const LAS f32x4*)(op + 4 * j); s += (ov[j][0] * ov[j][0] + ov[j][1] * ov[j][1]) + (ov[j][2] * ov[j][2] + ov[j][3] * ov[j][3]); }
          s += swz<1>(s); s += swz<2>(s); s += swz<4>(s);
          const float rs = rsqrtf(s * (1.0f / 128.0f) + EPS);
          const size_t go = ((size_t)b * SEQ + n * CHK + gtok) * 1024 + h * 128 + gseg * 16;
          float zf[16];
#pragma unroll
          for (int j = 0; j < 4; ++j) { zf[2 * j] = bflo(z0[j]); zf[2 * j + 1] = bfhi(z0[j]); zf[8 + 2 * j] = bflo(z1[j]); zf[8 + 2 * j + 1] = bfhi(z1[j]); }
          SCAN_LD_Z(n1);
          f32x4 q[4];
#pragma unroll
          for (int j = 0; j < 4; ++j) { const f32x4 gnj = *(const LAS f32x4*)(Gn + gseg * 16 + 4 * j);
#pragma unroll
              for (int e = 0; e < 4; ++e) q[j][e] = ov[j][e] * rs * gnj[e] * siluf_(zf[4 * j + e]); }
          *(u32x4*)(GO + go) = pack8u(q[0], q[1]); *(u32x4*)(GO + go + 8) = pack8u(q[2], q[3]); }
    }
    asm volatile("s_waitcnt vmcnt(0)" ::: "memory");
#undef SCAN_DMA
#undef SCAN_LD_U
#undef SCAN_LD_AA
#undef SCAN_LD_K
#undef SCAN_LD_Z
    LDS_BAR();
}
}

#define XB_TMO      128
#define XB_XCNT(j)  (256  + 64 * (j))
#define XB_XSUB(j)  (1280 + 64 * (j))
#define XB_XGEN(j)  (2304 + 64 * (j))
#define XB_TOP      3328
#define XB_TOPGEN   3392
#define XCD_BAR_WORDS 3456
#define XB_SPIN_CAP (1u << 18)
__device__ __forceinline__ unsigned xb_ld(unsigned* p)              { return __hip_atomic_load(p, __ATOMIC_RELAXED, __HIP_MEMORY_SCOPE_AGENT); }
__device__ __forceinline__ unsigned xb_add(unsigned* p, unsigned v) { return __hip_atomic_fetch_add(p, v, __ATOMIC_RELAXED, __HIP_MEMORY_SCOPE_AGENT); }
__device__ __forceinline__ unsigned xb_xcc_id() { return (unsigned)__builtin_amdgcn_s_getreg((3 << 11) | 20) & 0xFu; }
#define XB_SPIN(cond, bar) do { unsigned _sp = 0; while (cond) { __builtin_amdgcn_s_sleep(1); \
    if ((++_sp & 255u) == 0u) { if (xb_ld(&(bar)[XB_TMO])) break; if (_sp > XB_SPIN_CAP) { atomicAdd(&(bar)[XB_TMO], 1u); break; } } } } while (0)
struct XcdBarrier { unsigned* bar; unsigned x; volatile LAS unsigned* st; };
__device__ __forceinline__ XcdBarrier xcd_barrier_post(unsigned* bar, volatile LAS unsigned* st) {
    XcdBarrier b; b.bar = bar; b.x = xb_xcc_id(); b.st = st;
    if (threadIdx.x == 0) (void)xb_add(&bar[XB_XCNT(b.x)], 1u);
    return b;
}
__device__ __forceinline__ void xcd_barrier_complete(unsigned* bar, unsigned x, unsigned& nloc, unsigned& nx) {
    const unsigned G = gridDim.x * gridDim.y * gridDim.z;
    unsigned sum, cnt, mine, sp = 0u;
    for (;;) {
        sum = 0u; cnt = 0u; mine = 0u;
#pragma unroll
        for (unsigned j = 0; j < 16; ++j) { const unsigned c = xb_ld(&bar[XB_XCNT(j)]); sum += c; cnt += (c > 0u) ? 1u : 0u; mine = (j == x) ? c : mine; }
        if (sum == G) break;
        __builtin_amdgcn_s_sleep(1);
        if ((++sp & 255u) == 0u) { if (xb_ld(&bar[XB_TMO])) break; if (sp > XB_SPIN_CAP) { atomicAdd(&bar[XB_TMO], 1u); break; } }
    }
    nloc = mine > 0u ? mine : 1u; nx = cnt > 0u ? cnt : 1u;
}
__device__ __forceinline__ void xcd_barrier(const XcdBarrier& b) {
    asm volatile("s_waitcnt vmcnt(0)" ::: "memory");
    __syncthreads();
    if (threadIdx.x == 0) {
        unsigned* bar = b.bar;
        __builtin_amdgcn_s_waitcnt(0);
        unsigned nloc = b.st[0], nx = b.st[1];
        if (nloc == 0u) { xcd_barrier_complete(bar, b.x, nloc, nx); b.st[0] = nloc; b.st[1] = nx; }
        const unsigned old = xb_add(&bar[XB_XSUB(b.x)], 1u);
        const unsigned gen = old / nloc;
        if (old + 1u == (gen + 1u) * nloc) {
            __builtin_amdgcn_fence(__ATOMIC_RELEASE, "agent");
            asm volatile("s_waitcnt vmcnt(0)" ::: "memory");
            const unsigned og = xb_add(&bar[XB_TOP], 1u);
            const unsigned tg = og / nx;
            if (og + 1u == (tg + 1u) * nx) xb_add(&bar[XB_TOPGEN], 1u);
            else XB_SPIN(xb_ld(&bar[XB_TOPGEN]) == tg, bar);
            __builtin_amdgcn_fence(__ATOMIC_ACQUIRE, "agent");
            xb_add(&bar[XB_XGEN(b.x)], 1u);
            asm volatile("s_waitcnt vmcnt(0)" ::: "memory");
        } else {
            XB_SPIN(xb_ld(&bar[XB_XGEN(b.x)]) == gen, bar);
            __builtin_amdgcn_fence(__ATOMIC_ACQUIRE, "agent");
            asm volatile("s_waitcnt vmcnt(0)" ::: "memory");
        }
    }
    __syncthreads();
}

#ifndef PH_MASK
#define PH_MASK 0xFFFFF
#endif
#define PHE(k) ((PH_MASK >> (k)) & 1)
constexpr int NPHASE = 20;
__device__ __forceinline__ WDesc wdesc(const Params& p, int l, int i) {
    WDesc w; w.ksc = nullptr;
    switch (i) {
    case 0: w.src = p.w_in + (size_t)l * D * INW; w.dst = (bf16_t*)(p.ws + WS_WIN); w.K = D; w.Nsrc = INW; w.Ndst = INWP; w.type = WT_IN; break;
    case 1: w.src = p.w_uq + (size_t)l * 512 * 1536; w.dst = (bf16_t*)(p.ws + WS_WUQ); w.K = 512; w.Nsrc = 1536; w.Ndst = 1536; w.type = WT_UQ; w.ksc = p.q_a_norm + l * 512; break;
    case 2: w.src = p.w_ukv + (size_t)l * 512 * 2048; w.dst = (bf16_t*)(p.ws + WS_WUKV); w.K = 512; w.Nsrc = 2048; w.Ndst = 2048; w.type = WT_NAT; w.ksc = p.kv_a_norm + l * 512; break;
    case 3: w.src = p.w_o_mla + (size_t)l * 1024 * 2048; w.dst = (bf16_t*)(p.ws + WS_WOM); w.K = 1024; w.Nsrc = 2048; w.Ndst = 2048; w.type = WT_NAT; break;
    case 4: w.src = p.w_o_gdn + (size_t)l * 1024 * 2048; w.dst = (bf16_t*)(p.ws + WS_WOG); w.K = 1024; w.Nsrc = 2048; w.Ndst = 2048; w.type = WT_NAT; break;
    case 5: w.src = p.w_o + (size_t)l * 2048 * 2048; w.dst = (bf16_t*)(p.ws + WS_WO); w.K = 2048; w.Nsrc = 2048; w.Ndst = 2048; w.type = WT_NAT; break;
    case 6: w.src = p.w_gate_up + (size_t)l * 2048 * 11264; w.dst = (bf16_t*)(p.ws + AR_WGU); w.K = 2048; w.Nsrc = 11264; w.Ndst = 11264; w.type = WT_GU; break;
    default: w.src = p.w_down + (size_t)l * DFF * 2048; w.dst = (bf16_t*)(p.ws + AR_WDN); w.K = DFF; w.Nsrc = 2048; w.Ndst = 2048; w.type = WT_NAT; break;
    }
    return w;
}
__device__ __forceinline__ void conv_weights(LAS unsigned char* lds, const Params& p, int l, int i0, int i1, int skip) {
    int total = 0;
    for (int i = i0; i < i1; ++i) { const WDesc w = wdesc(p, l, i); total += wtiles(w); }
    int first = (int)blockIdx.x - (skip % (int)gridDim.x); if (first < 0) first += gridDim.x;
    for (int it = first; it < total; it += gridDim.x) {
        int it2 = it;
        for (int i = i0; i < i1; ++i) { const WDesc w = wdesc(p, l, i); const int n = wtiles(w); if (it2 < n) { conv_item(lds, w, it2); break; } it2 -= n; }
    }
}

__global__ void __launch_bounds__(NTHR) mega(Params p) {
    extern __shared__ __attribute__((aligned(16))) unsigned char smem[];
    LAS unsigned char* lds = (LAS unsigned char*)smem;
    cg::grid_group grid = cg::this_grid();
    unsigned char* ws = p.ws;
    float* MOD = (float*)(ws + WS_MOD); bf16_t* XA = (bf16_t*)(ws + WS_XA); bf16_t* H = (bf16_t*)(ws + WS_H);
    unsigned* ctr = (unsigned*)(ws + WS_CTL);
    volatile LAS unsigned* bst = (volatile LAS unsigned*)(lds + MISC_OFF + 16);
    if (threadIdx.x == 0) { bst[0] = 0u; bst[1] = 0u; }
    __syncthreads();
    const XcdBarrier xbar = xcd_barrier_post((unsigned*)(ws + WS_BAR), bst);
    for (int ph = p.ph_lo; ph < p.ph_hi; ++ph) {
        if (ph == 0) { if (PHE(0)) { for (int rp = 0; rp < (PROBE_SEL == 3 ? 2 : 1); ++rp) {
            { int t0 = threadIdx.x; asm volatile("" : "+v"(t0)); if (blockIdx.x == 0 && t0 < 64) ctr[t0] = 0u; }
            for (int it = blockIdx.x; it < 192 + 128; it += gridDim.x) { if (it < 192) ada_item(lds, p, it); else rope_item(p, it - 192); }
            conv_weights(lds, p, 0, 0, 6, 320); } }
        } else if (ph == NPHASE - 1) {
            if (PHE(10)) norm_rows<true, true>(nullptr, XA, p.final_norm, nullptr, 0, 0, nullptr, p.out);
        } else {
            const int l = (ph - 1) / 9, s = (ph - 1) % 9;
            const float* modl = MOD + (size_t)l * NB * 6 * D;
            switch (s) {
            case 0: if (PHE(1)) { if (l > 0) conv_weights(lds, p, l, 0, 6, 0);
                if (l == 0) norm_rows<false, false>(p.x, nullptr, p.norm_mix + l * D, modl, 0, 1, H, nullptr);
                else norm_rows<false, true>(nullptr, XA, p.norm_mix + l * D, modl, 0, 1, H, nullptr); } break;
            case 1: if (PHE(2)) { EpiIn e; e.CQ = (bf16_t*)(ws + AR_CQ); e.CKV = (bf16_t*)(ws + AR_CKV); e.QKVG = (bf16_t*)(ws + AR_QKVG); e.Z = (bf16_t*)(ws + AR_Z); e.GATE = (bf16_t*)(ws + AR_GATE);
                e.Kb = (bf16_t*)(ws + AR_K); e.SSQ = (float*)(ws + WS_SSQ); e.BA = (float*)(ws + WS_BA); e.COS = (const float*)(ws + WS_COS); e.SIN = (const float*)(ws + WS_SIN);
                pg8::gemm_phase(lds, pg8::Gemm{H, (const bf16_t*)(ws + WS_WIN), T, INWP, D}, e); } break;
            case 2: if (PHE(3)) { EpiQKV e; e.Q = (bf16_t*)(ws + AR_Q); e.Kb = (bf16_t*)(ws + AR_K); e.Vb = (bf16_t*)(ws + AR_V); e.SSQ = (const float*)(ws + WS_SSQ); e.COS = (const float*)(ws + WS_COS); e.SIN = (const float*)(ws + WS_SIN);
#ifndef NO_UP
#pragma unroll 1
                for (int g = 0; g < 2; ++g) { e.mode = g;
                    pg8::gemm_phase(lds, pg8::Gemm{(const bf16_t*)(ws + (g ? AR_CKV : AR_CQ)), (const bf16_t*)(ws + (g ? WS_WUKV : WS_WUQ)), T, g ? 2048 : 1536, 512}, e); }
#endif
#ifndef NO_PREP
                for (int rp = 0; rp < (PROBE_SEL == 2 ? 2 : 1); ++rp)
                for (int u = blockIdx.x; u < NB * NH * NCH; u += gridDim.x) gdn::prep_unit(lds, p, l, u);
#endif
                } break;
            case 3: if (PHE(4)) { for (int rp = 0; rp < (PROBE_SEL == 1 ? 2 : 1); ++rp) {
#if DBG_NO_SCAN
                { int t0 = threadIdx.x; asm volatile("" : "+v"(t0)); u32x4 z4 = {0u,0u,0u,0u}; for (size_t i = (size_t)blockIdx.x * NTHR + t0; i < (size_t)T * 1024 / 8; i += (size_t)gridDim.x * NTHR) ((u32x4*)(ws + AR_GO))[i] = z4; }
#else
                if (blockIdx.x < NB * NH) gdn::scan_unit(lds, p, l, blockIdx.x);
                if (PROBE_SEL == 5 && blockIdx.x < NB * NH) gdn::scan_unit(lds, p, l, blockIdx.x);
#endif
#if DBG_NO_ATT
                { int t0 = threadIdx.x; asm volatile("" : "+v"(t0)); u32x4 z4 = {0u,0u,0u,0u}; for (size_t i = (size_t)blockIdx.x * NTHR + t0; i < (size_t)T * 1024 / 8; i += (size_t)gridDim.x * NTHR) ((u32x4*)(ws + AR_AO))[i] = z4; }
#else
                LAS int* misc = (LAS int*)(lds + MISC_OFF);
                for (;;) { if (threadIdx.x == 0) misc[0] = (int)atomicAdd(ctr + l + 2 * rp, 1u);
                    __syncthreads(); const int i = misc[0]; __syncthreads();
                    if (i >= 512) break;
                    att::attn_unit(lds, (const bf16_t*)(ws + AR_Q), (const bf16_t*)(ws + AR_K), (const bf16_t*)(ws + AR_V), (bf16_t*)(ws + AR_AO), (i & 63) >> 3, i & 7, 7 - (i >> 6)); }
#endif
                } } break;
            case 4: if (PHE(5)) { EpiOut e; e.GATE = (const bf16_t*)(ws + AR_GATE); e.TMP = (float*)(ws + AR_TMP); e.MIX = (bf16_t*)(ws + AR_MIX);
#pragma unroll 1
                for (int g = 0; g < 2; ++g) { e.SECOND = g;
                    pg8::gemm_phase(lds, pg8::Gemm{(const bf16_t*)(ws + (g ? AR_GO : AR_AO)), (const bf16_t*)(ws + (g ? WS_WOG : WS_WOM)), T, 2048, 1024}, e); } } break;
            case 5: if (PHE(6)) { EpiResid e; e.XINF = (l == 0) ? p.x : nullptr; e.XIN16 = XA; e.XOUT = XA; e.GT = modl + 2 * D;
                pg8::gemm_phase(lds, pg8::Gemm{(const bf16_t*)(ws + AR_MIX), (const bf16_t*)(ws + WS_WO), T, 2048, 2048}, e); } break;
            case 6: if (PHE(7)) { for (int rp = 0; rp < (PROBE_SEL == 3 ? 2 : 1); ++rp) { conv_weights(lds, p, l, 6, 8, 0);
                norm_rows<false, true>(nullptr, XA, p.norm_ffn + l * D, modl, 3, 4, H, nullptr); } } break;
            case 7: if (PHE(8)) { EpiSwiGLU e; e.ACT = (bf16_t*)(ws + AR_ACT);
                pg8::gemm_phase(lds, pg8::Gemm{H, (const bf16_t*)(ws + AR_WGU), T, 11264, 2048}, e); } break;
            default: if (PHE(9)) { EpiResid e; e.XINF = nullptr; e.XIN16 = XA; e.XOUT = XA; e.GT = modl + 5 * D;
                pg8::gemm_phase(lds, pg8::Gemm{(const bf16_t*)(ws + AR_ACT), (const bf16_t*)(ws + AR_WDN), T, 2048, DFF}, e); } break;
            }
        }
        if (ph + 1 < p.ph_hi) { if (p.ph_hi < 0) grid.sync(); else xcd_barrier(xbar); }
    }
}

#ifndef MK_MULTI
#define MK_MULTI 0
#endif

#ifndef MK_REPS
#define MK_REPS 1
#endif
extern "C" void kernel_launch(void* const* d_in, const int* in_sizes, int n_in, void* d_out, int out_size, void* d_ws, size_t ws_size, hipStream_t stream) {
    static int grid = 0;
    if (grid == 0) {
        int dev = 0, cus = 0, per_cu = 0;
        (void)hipGetDevice(&dev);
        (void)hipDeviceGetAttribute(&cus, hipDeviceAttributeMultiprocessorCount, dev);
        if (hipFuncSetAttribute((const void*)mega, hipFuncAttributeMaxDynamicSharedMemorySize, LDS_BYTES) != hipSuccess) fprintf(stderr, "kernel_launch: hipFuncSetAttribute failed\n");
        if (hipOccupancyMaxActiveBlocksPerMultiprocessor(&per_cu, (const void*)mega, NTHR, LDS_BYTES) != hipSuccess || per_cu < 1) { fprintf(stderr, "kernel_launch: occupancy query says %d\n", per_cu); per_cu = 1; }
        (void)hipGetLastError();
        grid = cus * 1;
        if (grid <= 0) grid = 256;
        fprintf(stderr, "kernel_launch: grid %d (cus %d, per_cu %d), ws %zu need %zu\n", grid, cus, per_cu, ws_size, (size_t)WS_END);
    }
    if (ws_size < WS_END || n_in != 22) { (void)hipMemsetAsync(d_out, 0xFF, (size_t)out_size * 4, stream); return; }
    Params p{};
    p.x = (const float*)d_in[0]; p.c = (const float*)d_in[1]; p.pos = (const int*)d_in[2]; p.w_ada = (const float*)d_in[3]; p.b_ada = (const float*)d_in[4];
    p.norm_mix = (const float*)d_in[5]; p.norm_ffn = (const float*)d_in[6]; p.w_in = (const float*)d_in[7]; p.q_a_norm = (const float*)d_in[8]; p.kv_a_norm = (const float*)d_in[9];
    p.w_uq = (const float*)d_in[10]; p.w_ukv = (const float*)d_in[11]; p.w_o_mla = (const float*)d_in[12]; p.conv_w = (const float*)d_in[13]; p.A_log = (const float*)d_in[14];
    p.dt_bias = (const float*)d_in[15]; p.gdn_norm = (const float*)d_in[16]; p.w_o_gdn = (const float*)d_in[17]; p.w_o = (const float*)d_in[18]; p.w_gate_up = (const float*)d_in[19];
    p.w_down = (const float*)d_in[20]; p.final_norm = (const float*)d_in[21];
    p.out = (float*)d_out; p.ws = (unsigned char*)d_ws;
    (void)hipMemsetAsync((unsigned char*)d_ws + WS_BAR, 0, XCD_BAR_WORDS * 4, stream);
#if MK_MULTI
    for (int rep = 0; rep < MK_REPS; ++rep)
    for (int ph = 0; ph < NPHASE; ++ph) { p.ph_lo = ph; p.ph_hi = ph + 1; void* args[] = {&p};
        hipError_t e = hipLaunchCooperativeKernel((const void*)mega, dim3(grid), dim3(NTHR), args, LDS_BYTES, stream);
        if (e != hipSuccess) { fprintf(stderr, "cooperative launch failed: %s\n", hipGetErrorString(e)); break; } }
#else
    p.ph_lo = 0; p.ph_hi = NPHASE; void* args[] = {&p};
    hipError_t e = hipLaunchCooperativeKernel((const void*)mega, dim3(grid), dim3(NTHR), args, LDS_BYTES, stream);
    if (e != hipSuccess) fprintf(stderr, "cooperative launch failed: %s (grid %d)\n", hipGetErrorString(e), grid);
#endif
}
```

```cpp
#include <hip/hip_runtime.h>
#include <hip/hip_cooperative_groups.h>
#include <cstdio>
#include <cstdint>
namespace cg = cooperative_groups;
#define DBG_NO_ATT 0
#define DBG_NO_SCAN 0
#define PROBE_SEL 0

#define LAS __attribute__((address_space(3)))
typedef unsigned short bf16_t;
typedef short bf16x8 __attribute__((ext_vector_type(8)));
typedef short s16x4 __attribute__((ext_vector_type(4)));
typedef float f32x4 __attribute__((ext_vector_type(4)));
typedef float f32x16 __attribute__((ext_vector_type(16)));
typedef unsigned u32x4 __attribute__((ext_vector_type(4)));
typedef unsigned u32x2 __attribute__((ext_vector_type(2)));

constexpr int D = 2048, NB = 8, SEQ = 2048, T = NB * SEQ, DEPTH = 2;
constexpr int NH = 8, DQK = 192, QL = 512;
constexpr int CHK = 64, NCH = SEQ / CHK;
constexpr int DFF = 5632;
constexpr int INW = 9296, INWP = 9472;
constexpr float EPS = 1e-6f;
constexpr int NTHR = 512;
constexpr int LDS_BYTES = 156 * 1024;
constexpr int MISC_OFF = 155 * 1024;

constexpr size_t WS_CTL = 0;
constexpr size_t WS_BAR = 4096;
constexpr size_t WS_MOD = 32768;
constexpr size_t WS_COS = WS_MOD + (size_t)DEPTH * NB * 6 * D * 4;
constexpr size_t WS_SIN = WS_COS + (size_t)T * 32 * 4;
constexpr size_t WS_BA = WS_SIN + (size_t)T * 32 * 4;
constexpr size_t WS_SSQ = WS_BA + (size_t)T * 16 * 4;
constexpr size_t WS_EGL = WS_SSQ + (size_t)T * 16 * 4;
constexpr size_t WS_WIN = WS_EGL + 8192;
constexpr size_t WS_WUQ = WS_WIN + (size_t)INWP * D * 2;
constexpr size_t WS_WUKV = WS_WUQ + (size_t)1536 * 512 * 2;
constexpr size_t WS_WOM = WS_WUKV + (size_t)2048 * 512 * 2;
constexpr size_t WS_WOG = WS_WOM + (size_t)2048 * 1024 * 2;
constexpr size_t WS_WO = WS_WOG + (size_t)2048 * 1024 * 2;
constexpr size_t WS_XA = WS_WO + (size_t)2048 * 2048 * 2;
constexpr size_t WS_H = WS_XA + (size_t)T * D * 4;
constexpr size_t WS_AR = WS_H + (size_t)T * D * 2;
constexpr size_t AR_QKVG = WS_AR;
constexpr size_t AR_CQ = AR_QKVG + (size_t)T * 3072 * 2;
constexpr size_t AR_CKV = AR_CQ + (size_t)T * 512 * 2;
constexpr size_t AR_Z = AR_CKV + (size_t)T * 512 * 2;
constexpr size_t AR_GATE = AR_Z + (size_t)T * 1024 * 2;
constexpr size_t AR_Q = AR_GATE + (size_t)T * 4096 * 2;
constexpr size_t AR_K = AR_Q + (size_t)T * 1536 * 2;
constexpr size_t AR_V = AR_K + (size_t)T * 1536 * 2;
constexpr size_t AR_WG = AR_V + (size_t)T * 1024 * 2;
constexpr size_t AR_QG = AR_WG + (size_t)T * 1024 * 2;
constexpr size_t AR_KDT = AR_QG + (size_t)T * 1024 * 2;
constexpr size_t AR_ATT = AR_KDT + (size_t)T * 1024 * 2;
constexpr size_t AR_END = AR_ATT + (size_t)T * 8 * 64 * 2;
constexpr size_t AR_AO = AR_QKVG;
constexpr size_t AR_GO = AR_AO + (size_t)T * 1024 * 2;
constexpr size_t AR_TMP = AR_Q;
constexpr size_t AR_MIX = AR_WG;
constexpr size_t AR_ACT = WS_AR;
constexpr size_t AR_WGU = AR_ACT + (size_t)T * DFF * 2;
constexpr size_t AR_WDN = AR_WGU + (size_t)11264 * 2048 * 2;
constexpr size_t WS_END = AR_END;
static_assert(AR_WDN + (size_t)2048 * DFF * 2 <= AR_END, "ffn alias overflow");
static_assert(AR_TMP + (size_t)T * D * 4 <= AR_WG, "tmp alias");
static_assert(AR_MIX + (size_t)T * D * 2 <= AR_END, "mix alias");
static_assert(WS_END <= 846000000ull, "workspace");

struct Params {
    const float* x; const float* c; const int* pos; const float* w_ada; const float* b_ada; const float* norm_mix; const float* norm_ffn;
    const float* w_in; const float* q_a_norm; const float* kv_a_norm; const float* w_uq; const float* w_ukv; const float* w_o_mla;
    const float* conv_w; const float* A_log; const float* dt_bias; const float* gdn_norm; const float* w_o_gdn; const float* w_o;
    const float* w_gate_up; const float* w_down; const float* final_norm;
    float* out; unsigned char* ws; int ph_lo, ph_hi;
};

__constant__ float c_inv_freq[32] = {1.000000000e+00f, 7.498942018e-01f, 5.623413324e-01f, 4.216965139e-01f, 3.162277639e-01f, 2.371373773e-01f, 1.778279394e-01f, 1.333521456e-01f,
    1.000000015e-01f, 7.498942316e-02f, 5.623413250e-02f, 4.216964915e-02f, 3.162277490e-02f, 2.371373773e-02f, 1.778279431e-02f, 1.333521400e-02f,
    9.999999776e-03f, 7.498942316e-03f, 5.623413250e-03f, 4.216964822e-03f, 3.162277630e-03f, 2.371373819e-03f, 1.778279431e-03f, 1.333521446e-03f,
    1.000000047e-03f, 7.498941850e-04f, 5.623413017e-04f, 4.216965172e-04f, 3.162277571e-04f, 2.371373703e-04f, 1.778279402e-04f, 1.333521504e-04f};

typedef __bf16 bf16v2_t __attribute__((ext_vector_type(2)));
typedef float f32v2_t __attribute__((ext_vector_type(2)));
__device__ __forceinline__ unsigned cvt_pk_bf16(float lo, float hi) { const bf16v2_t r = __builtin_convertvector((f32v2_t){lo, hi}, bf16v2_t); return __builtin_bit_cast(unsigned, r); }
__device__ __forceinline__ bf16_t f2bf(float f) { unsigned u = __float_as_uint(f); u += 0x7FFFu + ((u >> 16) & 1u); return (bf16_t)(u >> 16); }
__device__ __forceinline__ float bf2f(bf16_t b) { return __uint_as_float(((unsigned)b) << 16); }
__device__ __forceinline__ float bflo(unsigned w) { return __uint_as_float(w << 16); }
__device__ __forceinline__ float bfhi(unsigned w) { return __uint_as_float(w & 0xffff0000u); }
__device__ __forceinline__ u32x4 pack8u(f32x4 a, f32x4 b) { u32x4 w = {cvt_pk_bf16(a[0], a[1]), cvt_pk_bf16(a[2], a[3]), cvt_pk_bf16(b[0], b[1]), cvt_pk_bf16(b[2], b[3])}; return w; }
__device__ __forceinline__ u32x2 pack4u(f32x4 a) { u32x2 w = {cvt_pk_bf16(a[0], a[1]), cvt_pk_bf16(a[2], a[3])}; return w; }
__device__ __forceinline__ float sigmoidf_(float x) { return __builtin_amdgcn_rcpf(1.0f + __expf(-x)); }
__device__ __forceinline__ float siluf_(float x) { return x * __builtin_amdgcn_rcpf(1.0f + __expf(-x)); }
template <int M> __device__ __forceinline__ float swz(float v) { return __int_as_float(__builtin_amdgcn_ds_swizzle(__float_as_int(v), (M << 10) | 0x1F)); }
__device__ __forceinline__ float halfsum(float v) { auto rr = __builtin_amdgcn_permlane32_swap(__float_as_uint(v), __float_as_uint(v), false, false); return __uint_as_float(rr[0]) + __uint_as_float(rr[1]); }
__device__ __forceinline__ float wave_sum(float s) { s += swz<1>(s); s += swz<2>(s); s += swz<4>(s); s += swz<8>(s); s += swz<16>(s); return halfsum(s); }
__device__ __forceinline__ int crow(int r, int hi) { return (r & 3) + 8 * (r >> 2) + 4 * hi; }
__device__ __forceinline__ int ropeperm(int j) { const int g = j >> 3, w = j & 7; return (w < 4) ? (4 * g + w) : (32 + 4 * g + (w - 4)); }

namespace pg8 {
constexpr int BM = 256, BK = 64, HALF = 128, HTB = HALF * BK * 2, STAGE_BYTES = 8 * HTB, NXCD = 8, WGM = 8;
__host__ __device__ __forceinline__ int lds_byte(int r, int c) { const int st = (r >> 4) * 2 + (c >> 5), rr = r & 15, cc = c & 31, ob = rr * 64 + cc * 2; return st * 1024 + (ob ^ (((ob >> 9) & 1) << 5)); }
__host__ __device__ __forceinline__ void stage_rc(int b, int& R, int& C) { const int st = b / 1024, sb = b % 1024, swz = sb ^ (((sb >> 9) & 1) << 5); R = (st >> 1) * 16 + swz / 64; C = (st & 1) * 32 + (swz % 64) / 2; }
__host__ __device__ __forceinline__ int perm32(int rho) { const int n = rho >> 4, i = rho & 15; return 8 * (i >> 2) + 4 * n + (i & 3); }
struct Unit { int pm, pn; };
struct Gemm { const bf16_t* A; const bf16_t* Bt; int M, N, K; };
struct StaticOrder {
    int nM, nN, nwg, G, c;
    __device__ void init(int M, int N, int G_, int c_) { nM = M / BM; nN = N / BM; nwg = nM * nN; G = G_; c = c_; }
    __device__ bool next(int i, Unit& u) const {
        const long L = (long)i * G + c; if (L >= nwg) return false;
        int wgid = (int)L; { const int q = nwg / NXCD, r = nwg % NXCD, xcd = wgid % NXCD, off = wgid / NXCD; wgid = (xcd < r ? xcd * (q + 1) : r * (q + 1) + (xcd - r) * q) + off; }
        const int nig = WGM * nN, gid = wgid / nig, fm = gid * WGM, gsz = (nM - fm) < WGM ? (nM - fm) : WGM;
        u.pm = fm + ((wgid % nig) % gsz); u.pn = (wgid % nig) / gsz; return true;
    }
};
template <class Epi>
__device__ __forceinline__ void gemm_phase(LAS unsigned char* lds, const Gemm g, const Epi& E) {
    int tid = threadIdx.x; asm volatile("" : "+v"(tid));
    int bid = blockIdx.x; asm volatile("" : "+s"(bid));
    StaticOrder S; S.init(g.M, g.N, (int)gridDim.x, bid);
    const int wid = __builtin_amdgcn_readfirstlane(tid >> 6), lane = tid & 63, wr = wid >> 2, wc = wid & 3, fr = lane & 15, fq = lane >> 4;
    const int K = g.K, nt = K / BK;
    unsigned voffA[2], voffB[2];
#pragma unroll
    for (int i = 0; i < 2; ++i) { int R, C; stage_rc(tid * 16 + i * 8192, R, C); const int Rb = Epi::PERM ? ((R & ~31) + perm32(R & 31)) : R;
        voffA[i] = (unsigned)(R * K + C) * 2u; voffB[i] = (unsigned)(Rb * K + C) * 2u; }
    const size_t kstep = (size_t)(BK * 2);
    const size_t hstep = (size_t)HALF * K * 2;
    const size_t tstep = 2 * hstep;
    const unsigned ldsw = (unsigned)wid * 1024u;
    const int aoff = lds_byte(wr * 64 + fr, fq * 8), boff = lds_byte(wc * 32 + fr, fq * 8);
#define PG8_SA(b, h) (((b) * 2 + (h)) * HTB)
#define PG8_SB(b, h) ((4 + (b) * 2 + (h)) * HTB)
#define PG8_STAGE(bufoff, gbase, voff) do { _Pragma("unroll") for (int _i = 0; _i < 2; ++_i) \
        __builtin_amdgcn_global_load_lds((const unsigned*)((const char*)(gbase) + (voff)[_i]), (LAS unsigned*)(lds + (bufoff) + ldsw + _i * 8192), 16, 0, 0); } while (0)
#define PG8_LDA(dst, b, h) do { _Pragma("unroll") for (int m = 0; m < 4; ++m) _Pragma("unroll") for (int k = 0; k < 2; ++k) dst[m][k] = *(const LAS bf16x8*)(lds + PG8_SA(b, h) + aoff + m * 2048 + k * 1024); } while (0)
#define PG8_LDB(dst, b, h) do { _Pragma("unroll") for (int n = 0; n < 2; ++n) _Pragma("unroll") for (int k = 0; k < 2; ++k) dst[n][k] = *(const LAS bf16x8*)(lds + PG8_SB(b, h) + boff + n * 2048 + k * 1024); } while (0)
#define PG8_MMA(ai, bj, At, Bt) do { __builtin_amdgcn_s_setprio(1); _Pragma("unroll") for (int m = 0; m < 4; ++m) _Pragma("unroll") for (int n = 0; n < 2; ++n) _Pragma("unroll") for (int k = 0; k < 2; ++k) \
        acc[ai][bj][m][n] = __builtin_amdgcn_mfma_f32_16x16x32_bf16(Bt[n][k], At[m][k], acc[ai][bj][m][n], 0, 0, 0); __builtin_amdgcn_s_setprio(0); } while (0)
#define PG8_WAIT_V(n) asm volatile("s_waitcnt vmcnt(" #n ")" ::: "memory")
#define PG8_WAIT_L(n) asm volatile("s_waitcnt lgkmcnt(" #n ")" ::: "memory")
#define PG8_BAR __builtin_amdgcn_s_barrier()
#define PG8_SCHED __builtin_amdgcn_sched_barrier(0)
    Unit cur, nxt; int ui = 0;
    if (S.next(0, cur)) {
    f32x4 acc[2][2][4][2];
#pragma unroll
    for (int a = 0; a < 2; ++a)
#pragma unroll
        for (int b = 0; b < 2; ++b)
#pragma unroll
            for (int m = 0; m < 4; ++m)
#pragma unroll
                for (int n = 0; n < 2; ++n) acc[a][b][m][n] = (f32x4){0.f, 0.f, 0.f, 0.f};
    bf16x8 At[4][2], B0[2][2], B1[2][2];
    const char* cA = (const char*)g.A + (size_t)cur.pm * tstep; const char* cB = (const char*)g.Bt + (size_t)cur.pn * tstep;
    PG8_STAGE(PG8_SB(0, 0), cB, voffB); PG8_STAGE(PG8_SA(0, 0), cA, voffA); PG8_STAGE(PG8_SB(0, 1), cB + hstep, voffB); PG8_STAGE(PG8_SA(0, 1), cA + hstep, voffA);
    if (wr == 1) PG8_BAR;
    PG8_WAIT_V(4); PG8_BAR;
    PG8_STAGE(PG8_SB(1, 0), cB + kstep, voffB); PG8_STAGE(PG8_SA(1, 0), cA + kstep, voffA); PG8_STAGE(PG8_SB(1, 1), cB + hstep + kstep, voffB);
    PG8_WAIT_V(6); PG8_BAR;
    for (;;) {
        const bool has_next = S.next(ui + 1, nxt);
        const char* nA = has_next ? (const char*)g.A + (size_t)nxt.pm * tstep : cA; const char* nB = has_next ? (const char*)g.Bt + (size_t)nxt.pn * tstep : cB;
        for (int t = 0; t < nt; t += 2) {
            const bool last = (t == nt - 2);
            const char* a1 = cA + (size_t)(t + 1) * kstep;
            const char* a2 = last ? nA : cA + (size_t)(t + 2) * kstep; const char* b2 = last ? nB : cB + (size_t)(t + 2) * kstep;
            const char* a3 = a2 + kstep; const char* b3 = b2 + kstep;
            PG8_LDB(B0, 0, 0); PG8_SCHED; PG8_LDA(At, 0, 0); PG8_STAGE(PG8_SA(1, 1), a1 + hstep, voffA);
            PG8_WAIT_L(8); PG8_BAR; PG8_WAIT_L(0); PG8_MMA(0, 0, At, B0); PG8_BAR; PG8_SCHED;
            PG8_LDB(B1, 0, 1); PG8_STAGE(PG8_SB(0, 0), b2, voffB);
            PG8_BAR; PG8_WAIT_L(0); PG8_MMA(0, 1, At, B1); PG8_BAR;
            PG8_LDA(At, 0, 1); PG8_STAGE(PG8_SA(0, 0), a2, voffA);
            PG8_BAR; PG8_WAIT_L(0); PG8_MMA(1, 0, At, B0); PG8_BAR; PG8_SCHED;
            PG8_STAGE(PG8_SB(0, 1), b2 + hstep, voffB);
            PG8_WAIT_V(6); PG8_BAR; PG8_MMA(1, 1, At, B1); PG8_BAR;
            PG8_LDB(B0, 1, 0); PG8_SCHED; PG8_LDA(At, 1, 0); PG8_STAGE(PG8_SA(0, 1), a2 + hstep, voffA);
            PG8_WAIT_L(8); PG8_BAR; PG8_WAIT_L(0); PG8_MMA(0, 0, At, B0); PG8_BAR; PG8_SCHED;
            PG8_LDB(B1, 1, 1); PG8_STAGE(PG8_SB(1, 0), b3, voffB);
            PG8_BAR; PG8_WAIT_L(0); PG8_MMA(0, 1, At, B1); PG8_BAR;
            PG8_LDA(At, 1, 1); PG8_STAGE(PG8_SA(1, 0), a3, voffA);
            PG8_BAR; PG8_WAIT_L(0); PG8_MMA(1, 0, At, B0); PG8_BAR; PG8_SCHED;
            PG8_STAGE(PG8_SB(1, 1), b3 + hstep, voffB);
            PG8_WAIT_V(6); PG8_BAR; PG8_MMA(1, 1, At, B1); PG8_BAR;
        }
        E(acc, cur, wr, wc, fr, fq);
        if (!has_next) break;
#pragma unroll
        for (int a = 0; a < 2; ++a)
#pragma unroll
            for (int b = 0; b < 2; ++b)
#pragma unroll
                for (int m = 0; m < 4; ++m)
#pragma unroll
                    for (int n = 0; n < 2; ++n) acc[a][b][m][n] = (f32x4){0.f, 0.f, 0.f, 0.f};
        cur = nxt; cA = nA; cB = nB; ++ui;
    }
    PG8_WAIT_V(0);
    if (wr == 0) PG8_BAR;
    PG8_BAR;
    }
    __syncthreads();
#undef PG8_SA
#undef PG8_SB
#undef PG8_STAGE
#undef PG8_LDA
#undef PG8_LDB
#undef PG8_MMA
#undef PG8_WAIT_V
#undef PG8_WAIT_L
#undef PG8_BAR
#undef PG8_SCHED
}
}
using pg8::Unit;
typedef f32x4 AccT[2][2][4][2];

struct EpiIn {
    static constexpr bool PERM = true;
    bf16_t* CQ; bf16_t* CKV; bf16_t* QKVG; bf16_t* Z; bf16_t* GATE; bf16_t* Kb; float* SSQ; float* BA; const float* COS; const float* SIN;
    __device__ __forceinline__ void operator()(const AccT& acc, const Unit& u, int wr, int wc, int fr, int fq) const {
        const int pn = u.pn;
        if (pn < 36) {
            bf16_t* base; int ld;
            if (pn < 4) { base = (pn < 2 ? CQ : CKV) + (pn & 1) * 256; ld = 512; }
            else if (pn < 16) { base = QKVG + (pn - 4) * 256; ld = 3072; }
            else if (pn < 20) { base = Z + (pn - 16) * 256; ld = 1024; }
            else { base = GATE + (pn - 20) * 256; ld = 4096; }
            base += wc * 32 + fq * 8;
#pragma unroll
            for (int ai = 0; ai < 2; ++ai)
#pragma unroll
                for (int m = 0; m < 4; ++m) {
                    const int row = u.pm * 256 + ai * 128 + wr * 64 + m * 16 + fr;
                    bf16_t* dst = base + (size_t)row * ld; float s = 0.f;
#pragma unroll
                    for (int bj = 0; bj < 2; ++bj) { f32x4 v0 = acc[ai][bj][m][0], v1 = acc[ai][bj][m][1];
                        if (pn < 4) s += (v0[0] * v0[0] + v0[1] * v0[1]) + (v0[2] * v0[2] + v0[3] * v0[3]) + (v1[0] * v1[0] + v1[1] * v1[1]) + (v1[2] * v1[2] + v1[3] * v1[3]);
                        if (pn >= 20) {
#pragma unroll
                            for (int j = 0; j < 4; ++j) { v0[j] = sigmoidf_(v0[j]); v1[j] = sigmoidf_(v1[j]); } }
                        *(u32x4*)(dst + bj * 128) = pack8u(v0, v1); }
                    if (pn < 4) { s += swz<16>(s); s = halfsum(s); if (fq == 0) SSQ[(size_t)row * 16 + pn * 4 + wc] = s; }
                }
        } else {
            const int g8 = wc * 4 + fq;
#pragma unroll
            for (int ai = 0; ai < 2; ++ai)
#pragma unroll
                for (int m = 0; m < 4; ++m) {
                    const int row = u.pm * 256 + ai * 128 + wr * 64 + m * 16 + fr;
                    const f32x4 v0 = acc[ai][0][m][0], v1 = acc[ai][0][m][1];
                    if (g8 < 8) {
                        const int i0 = 4 * g8;
                        const f32x4 cs = *(const f32x4*)(COS + (size_t)row * 32 + i0), sn = *(const f32x4*)(SIN + (size_t)row * 32 + i0);
                        const f32x4 o1 = v0 * cs - v1 * sn, o2 = v1 * cs + v0 * sn;
                        const u32x2 w1 = pack4u(o1), w2 = pack4u(o2);
                        const int b = row / SEQ, t = row % SEQ;
                        bf16_t* kp = Kb + ((size_t)(b * NH) * SEQ + t) * DQK + 128 + i0;
#pragma unroll
                        for (int h = 0; h < NH; ++h) { *(u32x2*)(kp + (size_t)h * SEQ * DQK) = w1; *(u32x2*)(kp + (size_t)h * SEQ * DQK + 32) = w2; }
                    } else if (g8 < 10) { float* bp = BA + (size_t)row * 16 + (g8 - 8) * 8; *(f32x4*)bp = v0; *(f32x4*)(bp + 4) = v1; }
                }
        }
    }
};
struct EpiQKV {
    static constexpr bool PERM = true;
    bf16_t* Q; bf16_t* Kb; bf16_t* Vb; const float* SSQ; const float* COS; const float* SIN; int mode;
    __device__ __forceinline__ void operator()(const AccT& acc, const Unit& u, int wr, int wc, int fr, int fq) const {
#pragma unroll
        for (int ai = 0; ai < 2; ++ai)
#pragma unroll
            for (int m = 0; m < 4; ++m) {
                const int row = u.pm * 256 + ai * 128 + wr * 64 + m * 16 + fr; const int b = row / SEQ, t = row % SEQ;
                const f32x4 s0 = *(const f32x4*)(SSQ + (size_t)row * 16 + mode * 8), s1 = *(const f32x4*)(SSQ + (size_t)row * 16 + mode * 8 + 4);
                const float ssq = (s0[0] + s0[1]) + (s0[2] + s0[3]) + (s1[0] + s1[1]) + (s1[2] + s1[3]);
                float rs = rsqrtf(ssq * (1.0f / 512.0f) + EPS);
                if (mode == 0) {
                    rs *= (0.07216878364870322f * 1.4426950408889634f);
#pragma unroll
                    for (int bj = 0; bj < 2; ++bj) {
                        const int c8 = u.pn * 256 + bj * 128 + wc * 32 + fq * 8; const int head = c8 / DQK, d0 = c8 % DQK;
                        bf16_t* qp = Q + ((size_t)(b * NH + head) * SEQ + t) * DQK;
                        const f32x4 v0 = acc[ai][bj][m][0] * rs, v1 = acc[ai][bj][m][1] * rs;
                        if (d0 < 128) { *(u32x4*)(qp + d0) = pack8u(v0, v1); }
                        else { const int i0 = 4 * ((d0 - 128) >> 3);
                            const f32x4 cs = *(const f32x4*)(COS + (size_t)row * 32 + i0), sn = *(const f32x4*)(SIN + (size_t)row * 32 + i0);
                            const f32x4 o1 = v0 * cs - v1 * sn, o2 = v1 * cs + v0 * sn;
                            *(u32x2*)(qp + 128 + i0) = pack4u(o1); *(u32x2*)(qp + 160 + i0) = pack4u(o2); }
                    }
                } else {
                    const size_t bh = (size_t)(b * NH + u.pn) * SEQ + t; const int d = wc * 32 + fq * 8;
                    *(u32x4*)(Kb + bh * DQK + d) = pack8u(acc[ai][0][m][0] * rs, acc[ai][0][m][1] * rs);
                    *(u32x4*)(Vb + bh * 128 + d) = pack8u(acc[ai][1][m][0] * rs, acc[ai][1][m][1] * rs);
                }
            }
    }
};
struct EpiOut {
    static constexpr bool PERM = true;
    const bf16_t* GATE; float* TMP; bf16_t* MIX; int SECOND;
    __device__ __forceinline__ void operator()(const AccT& acc, const Unit& u, int wr, int wc, int fr, int fq) const {
#pragma unroll
        for (int ai = 0; ai < 2; ++ai)
#pragma unroll
            for (int m = 0; m < 4; ++m) {
                const int row = u.pm * 256 + ai * 128 + wr * 64 + m * 16 + fr;
#pragma unroll
                for (int bj = 0; bj < 2; ++bj) {
                    const int c8 = u.pn * 256 + bj * 128 + wc * 32 + fq * 8;
                    const u32x4 gw = *(const u32x4*)(GATE + (size_t)row * 4096 + SECOND * 2048 + c8);
                    const f32x4 g0 = {bflo(gw[0]), bfhi(gw[0]), bflo(gw[1]), bfhi(gw[1])}, g1 = {bflo(gw[2]), bfhi(gw[2]), bflo(gw[3]), bfhi(gw[3])};
                    bf16_t* tp = (bf16_t*)TMP + (size_t)row * 2048 + c8;
                    if (SECOND == 0) { *(u32x4*)tp = pack8u(g0 * acc[ai][bj][m][0], g1 * acc[ai][bj][m][1]); }
                    else { const u32x4 tw = *(const u32x4*)tp;
                        const f32x4 t0 = {bflo(tw[0]), bfhi(tw[0]), bflo(tw[1]), bfhi(tw[1])}, t1 = {bflo(tw[2]), bfhi(tw[2]), bflo(tw[3]), bfhi(tw[3])};
                        const f32x4 a0 = t0 + g0 * acc[ai][bj][m][0], a1 = t1 + g1 * acc[ai][bj][m][1];
                        *(u32x4*)(MIX + (size_t)row * 2048 + c8) = pack8u(a0, a1); }
                }
            }
    }
};
struct EpiResid {
    static constexpr bool PERM = true;
    const float* XINF; const bf16_t* XIN16; bf16_t* XOUT; const float* GT;
    __device__ __forceinline__ void operator()(const AccT& acc, const Unit& u, int wr, int wc, int fr, int fq) const {
        const int b = (u.pm * 256) / SEQ;
        f32x4 gt[2][2];
#pragma unroll
        for (int bj = 0; bj < 2; ++bj)
#pragma unroll
            for (int n = 0; n < 2; ++n) gt[bj][n] = *(const f32x4*)(GT + (size_t)b * 6 * D + u.pn * 256 + bj * 128 + wc * 32 + fq * 8 + 4 * n);
#pragma unroll
        for (int ai = 0; ai < 2; ++ai)
#pragma unroll
            for (int m = 0; m < 4; ++m) {
                const int row = u.pm * 256 + ai * 128 + wr * 64 + m * 16 + fr;
#pragma unroll
                for (int bj = 0; bj < 2; ++bj) {
                    const size_t off = (size_t)row * D + u.pn * 256 + bj * 128 + wc * 32 + fq * 8;
                    f32x4 x0, x1;
                    if (XINF) { x0 = *(const f32x4*)(XINF + off); x1 = *(const f32x4*)(XINF + off + 4); }
                    else { const u32x4 w = *(const u32x4*)(XIN16 + off); x0 = (f32x4){bflo(w[0]), bfhi(w[0]), bflo(w[1]), bfhi(w[1])}; x1 = (f32x4){bflo(w[2]), bfhi(w[2]), bflo(w[3]), bfhi(w[3])}; }
                    *(u32x4*)(XOUT + off) = pack8u(x0 + gt[bj][0] * acc[ai][bj][m][0], x1 + gt[bj][1] * acc[ai][bj][m][1]);
                }
            }
    }
};
struct EpiSwiGLU {
    static constexpr bool PERM = true;
    bf16_t* ACT;
    __device__ __forceinline__ void operator()(const AccT& acc, const Unit& u, int wr, int wc, int fr, int fq) const {
#pragma unroll
        for (int ai = 0; ai < 2; ++ai)
#pragma unroll
            for (int m = 0; m < 4; ++m) {
                const int row = u.pm * 256 + ai * 128 + wr * 64 + m * 16 + fr;
                f32x4 o0, o1;
#pragma unroll
                for (int j = 0; j < 4; ++j) { o0[j] = siluf_(acc[ai][0][m][0][j]) * acc[ai][1][m][0][j]; o1[j] = siluf_(acc[ai][0][m][1][j]) * acc[ai][1][m][1][j]; }
                *(u32x4*)(ACT + (size_t)row * DFF + u.pn * 128 + wc * 32 + fq * 8) = pack8u(o0, o1);
            }
    }
};

enum { WT_IN = 0, WT_UQ, WT_UKV, WT_NAT, WT_GU };
__device__ __forceinline__ int wsrc_col(int type, int n) {
    switch (type) {
    case WT_IN: { const int pn = n >> 8, j = n & 255;
        if (pn < 4) return n;
        if (pn < 20) return 1088 + (n - 1024);
        if (pn < 36) return 5200 + (n - 5120);
        if (j < 64) return 1024 + ropeperm(j);
        if (j < 72) return 5184 + (j - 64);
        if (j < 80) return 5192 + (j - 72);
        return -1; }
    case WT_UQ: { const int h = n / DQK, d = n % DQK; return d < 128 ? n : h * DQK + 128 + ropeperm(d - 128); }
    case WT_GU: { const int pn = n >> 8, j = n & 255; return (j >> 7) * DFF + pn * 128 + (j & 127); }
    default: return n;
    }
}
__device__ __forceinline__ void conv_tile(LAS unsigned char* lds, const float* __restrict__ src, int Nsrc, bf16_t* __restrict__ dst, int K, int type, const float* __restrict__ ksc, int kt, int nt) {
    LAS bf16_t* tile = (LAS bf16_t*)lds;
    int tid = threadIdx.x; asm volatile("" : "+v"(tid));
    const int n4 = (tid & 63) * 4, kr = tid >> 6;
    const int sc = wsrc_col(type, nt * 256 + n4);
    f32x4 v[8];
#pragma unroll
    for (int i = 0; i < 8; ++i) { const int k = kt * 64 + kr + 8 * i; v[i] = (f32x4){0.f, 0.f, 0.f, 0.f};
        if (sc >= 0) { v[i] = *(const f32x4*)(src + (size_t)k * Nsrc + sc); if (ksc) v[i] *= ksc[k]; } }
#pragma unroll
    for (int i = 0; i < 8; ++i) {
#pragma unroll
        for (int j = 0; j < 4; ++j) tile[(n4 + j) * 72 + kr + 8 * i] = f2bf(v[i][j]); }
    __syncthreads();
#pragma unroll
    for (int e = 0; e < 4; ++e) { const int id = tid + e * NTHR, n2 = id >> 3, kc = id & 7;
        const u32x4 w = *(const LAS u32x4*)(tile + n2 * 72 + kc * 8);
        *(u32x4*)(dst + (size_t)(nt * 256 + n2) * K + kt * 64 + kc * 8) = w; }
    __syncthreads();
}
struct WDesc { const float* src; bf16_t* dst; const float* ksc; int K, Nsrc, Ndst, type; };
__device__ __forceinline__ void conv_item(LAS unsigned char* lds, const WDesc& w, int it) { const int nkt = w.K / 64; conv_tile(lds, w.src, w.Nsrc, w.dst, w.K, w.type, w.ksc, it % nkt, it / nkt); }
__device__ __forceinline__ int wtiles(const WDesc& w) { return (w.K / 64) * (w.Ndst / 256); }

__device__ __forceinline__ void ada_item(LAS unsigned char* lds, const Params& p, int item) {
    LAS float* sc = (LAS float*)lds;
    LAS float* red = (LAS float*)(lds + 65536);
    int tid = threadIdx.x; asm volatile("" : "+v"(tid));
    const int l = item / 96, col0 = (item % 96) * 128, cg4 = (tid & 31) * 4, ks = tid >> 5;
    for (int i = tid; i < NB * D; i += NTHR) sc[i] = siluf_(p.c[i]);
    __syncthreads();
    float acc[8][4];
#pragma unroll
    for (int b = 0; b < 8; ++b)
#pragma unroll
        for (int j = 0; j < 4; ++j) acc[b][j] = 0.f;
    const float* wp = p.w_ada + (size_t)l * D * 6 * D + (size_t)(ks * 128) * 6 * D + col0 + cg4;
#pragma unroll 16
    for (int k = 0; k < 128; ++k) { const f32x4 w = *(const f32x4*)(wp + (size_t)k * 6 * D);
#pragma unroll
        for (int b = 0; b < 8; ++b) { const float s = sc[b * D + ks * 128 + k];
#pragma unroll
            for (int j = 0; j < 4; ++j) acc[b][j] += s * w[j]; } }
#pragma unroll
    for (int b = 0; b < 8; ++b) *(LAS f32x4*)(red + (ks * 8 + b) * 128 + cg4) = (f32x4){acc[b][0], acc[b][1], acc[b][2], acc[b][3]};
    __syncthreads();
    for (int o = tid; o < 8 * 128; o += NTHR) { const int b = o >> 7, cc = o & 127; float s = 0.f;
#pragma unroll
        for (int k2 = 0; k2 < 16; ++k2) s += red[(k2 * 8 + b) * 128 + cc];
        float* mod = (float*)(p.ws + WS_MOD);
        mod[((size_t)l * NB + b) * 6 * D + col0 + cc] = s + p.b_ada[(size_t)l * 6 * D + col0 + cc]; }
    __syncthreads();
}
__device__ __forceinline__ void rope_item(const Params& p, int item) {
    float* COS = (float*)(p.ws + WS_COS); float* SIN = (float*)(p.ws + WS_SIN);
    int tid = threadIdx.x; asm volatile("" : "+v"(tid));
#pragma unroll
    for (int e = 0; e < 8; ++e) { const int idx = item * 4096 + e * NTHR + tid; const int t = idx >> 5, i = idx & 31;
        const float ang = (float)p.pos[t] * c_inv_freq[i];
        const double a = (double)ang; const double k = rint(a * 0.15915494309189535); const float r = (float)(a - k * 6.283185307179586);
        COS[idx] = __cosf(r); SIN[idx] = __sinf(r); }
}

template <bool FINAL, bool SRC16 = false>
__device__ __forceinline__ void norm_rows(const float* __restrict__ xin, const bf16_t* __restrict__ xin16, const float* __restrict__ w, const float* __restrict__ modl, int sh_k, int sc_k, bf16_t* __restrict__ dst, float* __restrict__ fout) {
    int tid = threadIdx.x; asm volatile("" : "+v"(tid));
    const int lane = tid & 63, gw = blockIdx.x * 8 + (tid >> 6), nw = gridDim.x * 8;
    for (int row = gw; row < T; row += nw) {
        const int b = row / SEQ;
        if (SRC16) {
            f32x4 v[4][2]; float s = 0.f;
#pragma unroll
            for (int i = 0; i < 4; ++i) { const u32x4 r4 = *(const u32x4*)(xin16 + (size_t)row * D + (i * 64 + lane) * 8);
                v[i][0] = (f32x4){bflo(r4[0]), bfhi(r4[0]), bflo(r4[1]), bfhi(r4[1])}; v[i][1] = (f32x4){bflo(r4[2]), bfhi(r4[2]), bflo(r4[3]), bfhi(r4[3])};
#pragma unroll
                for (int hh = 0; hh < 2; ++hh) s += (v[i][hh][0] * v[i][hh][0] + v[i][hh][1] * v[i][hh][1]) + (v[i][hh][2] * v[i][hh][2] + v[i][hh][3] * v[i][hh][3]); }
            s = wave_sum(s);
            const float rs = rsqrtf(s * (1.0f / D) + EPS);
#pragma unroll
            for (int i = 0; i < 4; ++i) { const int c = (i * 64 + lane) * 8; f32x4 o[2];
#pragma unroll
                for (int hh = 0; hh < 2; ++hh) { const f32x4 ww = *(const f32x4*)(w + c + 4 * hh);
                    if (FINAL) o[hh] = v[i][hh] * rs * ww;
                    else { const f32x4 sh = *(const f32x4*)(modl + (size_t)b * 6 * D + sh_k * D + c + 4 * hh), sc = *(const f32x4*)(modl + (size_t)b * 6 * D + sc_k * D + c + 4 * hh);
                        o[hh] = v[i][hh] * rs * ww * (sc + 1.0f) + sh; } }
                if (FINAL) { *(f32x4*)(fout + (size_t)row * D + c) = o[0]; *(f32x4*)(fout + (size_t)row * D + c + 4) = o[1]; }
                else *(u32x4*)(dst + (size_t)row * D + c) = pack8u(o[0], o[1]); }
        } else {
            f32x4 v[8]; float s = 0.f;
#pragma unroll
            for (int i = 0; i < 8; ++i) { v[i] = *(const f32x4*)(xin + (size_t)row * D + (i * 64 + lane) * 4);
                s += (v[i][0] * v[i][0] + v[i][1] * v[i][1]) + (v[i][2] * v[i][2] + v[i][3] * v[i][3]); }
            s = wave_sum(s);
            const float rs = rsqrtf(s * (1.0f / D) + EPS);
#pragma unroll
            for (int i = 0; i < 8; ++i) { const int c = (i * 64 + lane) * 4; const f32x4 ww = *(const f32x4*)(w + c);
                if (FINAL) { *(f32x4*)(fout + (size_t)row * D + c) = v[i] * rs * ww; }
                else { const f32x4 sh = *(const f32x4*)(modl + (size_t)b * 6 * D + sh_k * D + c), sc = *(const f32x4*)(modl + (size_t)b * 6 * D + sc_k * D + c);
                    const f32x4 o = v[i] * rs * ww * (sc + 1.0f) + sh; *(u32x2*)(dst + (size_t)row * D + c) = pack4u(o); } }
        }
    }
}
#define LDS_BAR() do { asm volatile("s_waitcnt lgkmcnt(0)" ::: "memory"); __builtin_amdgcn_s_barrier(); asm volatile("" ::: "memory"); } while (0)
namespace att {
constexpr int KVBLK = 64, QB = 256, SHM_V = KVBLK * 128 * 2, SHM_K = KVBLK * DQK * 2;
constexpr int OFF_V = 0, OFF_K = 3 * SHM_V, OFF_W = OFF_K + 3 * SHM_K;
static_assert(OFF_W + 2048 <= MISC_OFF, "attention LDS");
__device__ __forceinline__ int v_st(int k, int c) { const int kk = (k & ~0xC) | ((k & 4) << 1) | ((k & 8) >> 1); return ((kk >> 3) * 4 + (c >> 5)) * 512 + ((kk & 7) * 32 + (c & 31)) * 2; }
__device__ __forceinline__ int v_rd_base(int lane) { return ((lane & 3) << 3) | (((lane >> 2) & 3) << 6) | (((lane >> 4) & 1) << 5) | (((lane >> 5) & 1) << 8); }
constexpr int v_rd_off(int d0, int ks, int half) { return d0 * 512 + ks * 4096 + half * 2048; }
#define ATT_SBAR() __builtin_amdgcn_sched_barrier(0)
constexpr float THR = 8.f;
__device__ __forceinline__ void partialSM(f32x16& p0, f32x16& p1, float& m_reg, float& alpha) {
    float pmax = p0[0];
#pragma unroll
    for (int r = 1; r < 16; ++r) pmax = fmaxf(pmax, p0[r]);
#pragma unroll
    for (int r = 0; r < 16; ++r) pmax = fmaxf(pmax, p1[r]);
    { auto rr = __builtin_amdgcn_permlane32_swap(__float_as_uint(pmax), __float_as_uint(pmax), false, false);
      pmax = fmaxf(__uint_as_float(rr[0]), __uint_as_float(rr[1])); }
    float mn;
    if (__all((pmax - m_reg) <= THR)) { mn = m_reg; alpha = 1.f; }
    else { mn = fmaxf(m_reg, pmax); alpha = __builtin_amdgcn_exp2f(m_reg - mn); m_reg = mn; }
#pragma unroll
    for (int r = 0; r < 16; ++r) { p0[r] = __builtin_amdgcn_exp2f(p0[r] - mn); p1[r] = __builtin_amdgcn_exp2f(p1[r] - mn); }
}
__device__ __forceinline__ void finishSM(const f32x16& p0, const f32x16& p1, float alpha, float& l_reg, bf16x8& pa0, bf16x8& pa1, bf16x8& pa2, bf16x8& pa3) {
    float ps = 0;
#pragma unroll
    for (int r = 0; r < 16; ++r) ps += p0[r];
#pragma unroll
    for (int r = 0; r < 16; ++r) ps += p1[r];
    { auto rr = __builtin_amdgcn_permlane32_swap(__float_as_uint(ps), __float_as_uint(ps), false, false);
      ps = __uint_as_float(rr[0]) + __uint_as_float(rr[1]); }
    l_reg = l_reg * alpha + ps;
#define PK4(P, B_, OUT) do { unsigned a0 = cvt_pk_bf16(P[B_+0], P[B_+1]), a1 = cvt_pk_bf16(P[B_+2], P[B_+3]);                          \
        unsigned b0 = cvt_pk_bf16(P[B_+4], P[B_+5]), b1 = cvt_pk_bf16(P[B_+6], P[B_+7]);                                             \
        auto r0 = __builtin_amdgcn_permlane32_swap(a0, b0, false, false); auto r1 = __builtin_amdgcn_permlane32_swap(a1, b1, false, false); \
        u32x4 w = {r0[0], r1[0], r0[1], r1[1]}; OUT = *reinterpret_cast<bf16x8*>(&w); } while (0)
    PK4(p0, 0, pa0); PK4(p0, 8, pa1); PK4(p1, 0, pa2); PK4(p1, 8, pa3);
#undef PK4
}
template <int KB>
__device__ __forceinline__ void qkt(f32x16& p0, f32x16& p1, const LAS char* K_lds, int r32, int hi, const bf16x8* qr) {
    p0 = f32x16{}; p1 = f32x16{};
    const LAS char* kb[4];
#pragma unroll
    for (int dd = 0; dd < 4; ++dd) kb[dd] = K_lds + KB * SHM_K + r32 * 384 + (((2 * dd + hi) ^ ((r32 >> 1) & 7)) << 4);
#pragma unroll
    for (int d0 = 0; d0 < 12; ++d0) { const LAS char* a = kb[d0 & 3] + (d0 >> 2) * 128;
        bf16x8 b0 = *(const LAS bf16x8*)(a);
        bf16x8 b1 = *(const LAS bf16x8*)(a + 32 * 384);
        p0 = __builtin_amdgcn_mfma_f32_32x32x16_bf16(b0, qr[d0], p0, 0, 0, 0);
        p1 = __builtin_amdgcn_mfma_f32_32x32x16_bf16(b1, qr[d0], p1, 0, 0, 0); }
}
template <int VB>
__device__ __forceinline__ void pv_tile(f32x16* o, int vb0, bf16x8 pa0, bf16x8 pa1, bf16x8 pa2, bf16x8 pa3) {
#define TRRD(dst, off) asm volatile("ds_read_b64_tr_b16 %0, %1 offset:%2" : "=&v"(dst) : "v"(vb0), "i"(off) : "memory")
#define PV_D0(d0) do { s16x4 l0, l1, l2, l3, h0, h1, h2, h3; constexpr int b_ = VB * SHM_V + v_rd_off(d0, 0, 0); \
        TRRD(l0, b_); TRRD(h0, b_ + 2048); TRRD(l1, b_ + 4096); TRRD(h1, b_ + 6144); TRRD(l2, b_ + 8192); TRRD(h2, b_ + 10240); TRRD(l3, b_ + 12288); TRRD(h3, b_ + 14336); \
        asm volatile("s_waitcnt lgkmcnt(0)" ::: "memory"); ATT_SBAR();   \
        o[d0] = __builtin_amdgcn_mfma_f32_32x32x16_bf16(pa0, (bf16x8){l0[0], l0[1], l0[2], l0[3], h0[0], h0[1], h0[2], h0[3]}, o[d0], 0, 0, 0);   \
        o[d0] = __builtin_amdgcn_mfma_f32_32x32x16_bf16(pa1, (bf16x8){l1[0], l1[1], l1[2], l1[3], h1[0], h1[1], h1[2], h1[3]}, o[d0], 0, 0, 0);   \
        o[d0] = __builtin_amdgcn_mfma_f32_32x32x16_bf16(pa2, (bf16x8){l2[0], l2[1], l2[2], l2[3], h2[0], h2[1], h2[2], h2[3]}, o[d0], 0, 0, 0);   \
        o[d0] = __builtin_amdgcn_mfma_f32_32x32x16_bf16(pa3, (bf16x8){l3[0], l3[1], l3[2], l3[3], h3[0], h3[1], h3[2], h3[3]}, o[d0], 0, 0, 0); } while (0)
    PV_D0(0); PV_D0(1); PV_D0(2); PV_D0(3);
#undef PV_D0
#undef TRRD
}
__device__ __forceinline__ void attn_unit(LAS unsigned char* lds, const bf16_t* __restrict__ Q, const bf16_t* __restrict__ Kg, const bf16_t* __restrict__ Vg, bf16_t* __restrict__ AO, int b, int h, int qb) {
    int tid = threadIdx.x; asm volatile("" : "+v"(tid));
    const int wid = __builtin_amdgcn_readfirstlane(tid >> 6), lane = tid & 63, r32 = lane & 31, hi = lane >> 5;
    const int P0 = qb * QB, NT = 4 * (qb + 1), qlo = P0 + wid * 32;
    const bf16_t* Qp = Q + (size_t)(b * NH + h) * SEQ * DQK; const bf16_t* Kp = Kg + (size_t)(b * NH + h) * SEQ * DQK; const bf16_t* Vp = Vg + (size_t)(b * NH + h) * SEQ * 128;
    const LAS char* K_lds = (const LAS char*)lds + OFF_K;
    LAS float* ws = (LAS float*)(lds + OFF_W) + wid * 64; LAS float* li_l = ws; LAS float* al_l = ws + 32;
    bf16x8 qr[12];
#pragma unroll
    for (int d0 = 0; d0 < 12; ++d0) qr[d0] = *(const bf16x8*)(Qp + (size_t)(qlo + r32) * DQK + d0 * 16 + hi * 8);
    int vso0;
    { const int o = tid * 16, sub = o >> 9, rem = (o & 511) >> 1; const int kk = (sub >> 2) * 8 + (rem >> 5), c = (sub & 3) * 32 + (rem & 31);
      const int k = (kk & ~0xC) | ((kk & 4) << 1) | ((kk & 8) >> 1); vso0 = k * 128 + c; }
#define ATT_LOAD(t_, bf_) do { const bf16_t* kk_ = Kp + (size_t)(t_) * KVBLK * DQK; const bf16_t* vv_ = Vp + (size_t)(t_) * KVBLK * 128; int tt_ = tid; asm volatile("" : "+v"(tt_)); \
        _Pragma("unroll") for (int i = 0; i < 3; ++i) { const int id = tt_ + i * NTHR, row = id / 24, cc = id % 24; \
            __builtin_amdgcn_global_load_lds((const unsigned*)(kk_ + row * DQK + ((cc ^ ((row >> 1) & 7)) << 3)), (LAS unsigned*)(lds + OFF_K + (bf_) * SHM_K + (i * NTHR + wid * 64) * 16), 16, 0, 0); } \
        _Pragma("unroll") for (int i = 0; i < 2; ++i) __builtin_amdgcn_global_load_lds((const unsigned*)(vv_ + vso0 + i * 32 * 128), (LAS unsigned*)(lds + OFF_V + (bf_) * SHM_V + (i * NTHR + wid * 64) * 16), 16, 0, 0); } while (0)
    ATT_LOAD(0, 0);
    if (NT > 1) { ATT_LOAD(1, 1); asm volatile("s_waitcnt vmcnt(5)" ::: "memory"); } else { asm volatile("s_waitcnt vmcnt(0)" ::: "memory"); }
    LDS_BAR();
    float m_reg = -1e30f, l_reg = 0.f; f32x16 o[4] = {};
    const int vb0 = (int)(unsigned)(uintptr_t)(lds + OFF_V) + v_rd_base(lane);
#define ATT_STEP(BI) do { \
        if (kb <= qlo + 31) {                                                 \
            f32x16 p0, p1; float alpha; bf16x8 pa0, pa1, pa2, pa3; \
            qkt<BI>(p0, p1, K_lds, r32, hi, qr); \
            if (kb + KVBLK - 1 > qlo) {                                       \
                const int dq = qlo + r32 - kb - 4 * hi; const float NEG = -__builtin_inff(); \
                _Pragma("unroll") for (int r = 0; r < 16; ++r) { const int c = (r & 3) + 8 * (r >> 2); if (dq - c < 0) p0[r] = NEG; if (dq - c - 32 < 0) p1[r] = NEG; } \
            } \
            partialSM(p0, p1, m_reg, alpha); \
            if (__any(alpha < 1.f)) { if (hi == 0) al_l[r32] = alpha; asm volatile("s_waitcnt lgkmcnt(0)" ::: "memory"); \
                _Pragma("unroll") for (int d_ = 0; d_ < 4; ++d_) _Pragma("unroll") for (int r = 0; r < 16; ++r) o[d_][r] *= al_l[crow(r, hi)]; } \
            finishSM(p0, p1, alpha, l_reg, pa0, pa1, pa2, pa3); ATT_SBAR(); \
            pv_tile<BI>(o, vb0, pa0, pa1, pa2, pa3); \
        } } while (0)
    int bi = 0;
#pragma unroll 1
    for (int t = 0; t < NT; ++t) {
        const int kb = t * KVBLK;
        if (t + 2 < NT) { if (bi == 0) ATT_LOAD(t + 2, 2); else if (bi == 1) ATT_LOAD(t + 2, 0); else ATT_LOAD(t + 2, 1); }
        if (bi == 0) ATT_STEP(0); else if (bi == 1) ATT_STEP(1); else ATT_STEP(2);
        if (t + 2 < NT) asm volatile("s_waitcnt vmcnt(5)" ::: "memory"); else asm volatile("s_waitcnt vmcnt(0)" ::: "memory");
        LDS_BAR();
        bi = (bi == 2) ? 0 : bi + 1;
    }
#undef ATT_STEP
    if (hi == 0) li_l[r32] = l_reg; asm volatile("s_waitcnt lgkmcnt(0)" ::: "memory");
    bf16_t* Ow = AO + ((size_t)b * SEQ + qlo) * 1024 + h * 128;
#pragma unroll
    for (int r = 0; r < 16; ++r) { const int orow = crow(r, hi); const float rl = __builtin_amdgcn_rcpf(li_l[orow]);
#pragma unroll
        for (int d0 = 0; d0 < 4; ++d0) { const float v = o[d0][r] * rl; const float vn = swz<1>(v);
            if ((r32 & 1) == 0) *(unsigned*)(Ow + (size_t)orow * 1024 + d0 * 32 + r32) = cvt_pk_bf16(v, vn); } }
    __syncthreads();
#undef ATT_LOAD
}
}

namespace gdn {
constexpr int XS = 132;
constexpr int OFF_XQ = 0, OFF_XK = 64 * XS * 4, OFF_XV = 2 * 64 * XS * 4, OFF_LM = 3 * 64 * XS * 4, OFF_BETA = OFF_LM + 64 * 64 * 4, OFF_G = OFF_BETA + 256, OFF_EG = OFF_G + 256, OFF_TI = OFF_EG + 256;
__device__ __forceinline__ void prep_unit(LAS unsigned char* lds, const Params& p, int l, int unit) {
    int tid = threadIdx.x; asm volatile("" : "+v"(tid));
    const int wid = tid >> 6, lane = tid & 63;
    const int b = unit / (NH * NCH), h = (unit / NCH) % NH, n = unit % NCH;
    const int row0 = b * SEQ + n * CHK;
    LAS float* Xq = (LAS float*)(lds + OFF_XQ); LAS float* Xk = (LAS float*)(lds + OFF_XK); LAS float* Xv = (LAS float*)(lds + OFF_XV);
    LAS float* Lm = (LAS float*)(lds + OFF_LM); LAS float* beta = (LAS float*)(lds + OFF_BETA); LAS float* Gc = (LAS float*)(lds + OFF_G); LAS float* eG = (LAS float*)(lds + OFF_EG);
    const bf16_t* QKVG = (const bf16_t*)(p.ws + AR_QKVG); const float* BA = (const float*)(p.ws + WS_BA);
    float* U = (float*)(p.ws + WS_H); bf16_t* Wg = (bf16_t*)(p.ws + AR_WG); bf16_t* QG = (bf16_t*)(p.ws + AR_QG); bf16_t* KDT = (bf16_t*)(p.ws + AR_KDT); bf16_t* ATT = (bf16_t*)(p.ws + AR_ATT);
    float* EGL = (float*)(p.ws + WS_EGL);
#ifndef NO_CONV
    for (int rpc = 0; rpc < (PROBE_SEL == 7 ? 2 : 1); ++rpc)
    if (tid < 384) {
        const int cgp = tid % 48, rg = tid / 48, mat = cgp / 16, c8 = (cgp % 16) * 8, col = mat * 1024 + h * 128 + c8;
        float wj[4][8];
#pragma unroll
        for (int j = 0; j < 4; ++j) { const float* wp = p.conv_w + ((size_t)l * 4 + j) * 3072 + col; const f32x4 a = *(const f32x4*)wp, c = *(const f32x4*)(wp + 4);
            wj[j][0] = a[0]; wj[j][1] = a[1]; wj[j][2] = a[2]; wj[j][3] = a[3]; wj[j][4] = c[0]; wj[j][5] = c[1]; wj[j][6] = c[2]; wj[j][7] = c[3]; }
        float u[11][8];
#pragma unroll
        for (int k = 0; k < 11; ++k) { const int tt = n * CHK + rg * 8 - 3 + k;
            u32x4 w = {0u, 0u, 0u, 0u};
            if (tt >= 0) w = *(const u32x4*)(QKVG + (size_t)(b * SEQ + tt) * 3072 + col);
            u[k][0] = bflo(w[0]); u[k][1] = bfhi(w[0]); u[k][2] = bflo(w[1]); u[k][3] = bfhi(w[1]); u[k][4] = bflo(w[2]); u[k][5] = bfhi(w[2]); u[k][6] = bflo(w[3]); u[k][7] = bfhi(w[3]); }
        LAS float* X = (mat == 0) ? Xq : (mat == 1 ? Xk : Xv);
#pragma unroll
        for (int i = 0; i < 8; ++i) { f32x4 y0, y1;
#pragma unroll
            for (int c = 0; c < 8; ++c) { float y = wj[0][c] * u[i][c] + wj[1][c] * u[i + 1][c] + wj[2][c] * u[i + 2][c] + wj[3][c] * u[i + 3][c]; y = siluf_(y); if (c < 4) y0[c] = y; else y1[c - 4] = y; }
            *(LAS f32x4*)(X + (rg * 8 + i) * XS + c8) = y0; *(LAS f32x4*)(X + (rg * 8 + i) * XS + c8 + 4) = y1; }
    }
#endif
    LDS_BAR();
#pragma unroll
    for (int mat = 0; mat < 2; ++mat) { LAS float* X = (mat ? Xk : Xq) + (tid >> 3) * XS + (tid & 7) * 16;
        f32x4 v[4]; float s = 0.f;
#pragma unroll
        for (int j = 0; j < 4; ++j) { v[j] = *(const LAS f32x4*)(X + 4 * j); s += (v[j][0] * v[j][0] + v[j][1] * v[j][1]) + (v[j][2] * v[j][2] + v[j][3] * v[j][3]); }
        s += swz<1>(s); s += swz<2>(s); s += swz<4>(s);
        const float sc = rsqrtf(s + EPS) * (mat ? 1.0f : 0.08838834764831845f);
#pragma unroll
        for (int j = 0; j < 4; ++j) *(LAS f32x4*)(X + 4 * j) = v[j] * sc; }
    if (wid == 0) {
        const float bl = BA[(size_t)(row0 + lane) * 16 + h], al = BA[(size_t)(row0 + lane) * 16 + 8 + h];
        const float xx = al + p.dt_bias[l * NH + h];
        const float sp = fmaxf(xx, 0.f) + log1pf(__expf(-fabsf(xx)));
        const float g0 = -__expf(p.A_log[l * NH + h]) * sp;
        Gc[lane] = g0; asm volatile("s_waitcnt lgkmcnt(0)" ::: "memory");
        float g = 0.f;
#pragma unroll 8
        for (int j = 0; j < 64; ++j) { const float gj = Gc[j]; g += (j <= lane) ? gj : 0.f; }
        asm volatile("s_waitcnt lgkmcnt(0)" ::: "memory");
        beta[lane] = sigmoidf_(bl); eG[lane] = __expf(g); Gc[lane] = g;
        if (lane == 63) EGL[unit] = __expf(g);
    }
    LDS_BAR();
    for (int rp3 = 0; rp3 < (PROBE_SEL == 8 ? 2 : 1); ++rp3)
#pragma unroll 1
    for (int tt = 0; tt < 2; ++tt) { const int ti = wid * 2 + tt, it = ti >> 2, jt = ti & 3;
        f32x4 aKK = {0.f, 0.f, 0.f, 0.f}, aQK = {0.f, 0.f, 0.f, 0.f};
        if (jt <= it) {
            const LAS float* pk = Xk + (16 * it + (lane & 15)) * XS + (lane >> 4); const LAS float* pq = Xq + (16 * it + (lane & 15)) * XS + (lane >> 4);
            const LAS float* pb = Xk + (16 * jt + (lane & 15)) * XS + (lane >> 4);
#pragma unroll 8
            for (int d = 0; d < 128; d += 4) { const float ak = pk[d], aq = pq[d], bk = pb[d];
                aKK = __builtin_amdgcn_mfma_f32_16x16x4f32(ak, bk, aKK, 0, 0, 0); aQK = __builtin_amdgcn_mfma_f32_16x16x4f32(aq, bk, aQK, 0, 0, 0); }
        }
#pragma unroll
        for (int r = 0; r < 4; ++r) { const int ig = 16 * it + 4 * (lane >> 4) + r, jg = 16 * jt + (lane & 15);
            const float dec = (ig >= jg) ? __expf(Gc[ig] - Gc[jg]) : 0.f;
            Lm[ig * 64 + jg] = (ig > jg) ? beta[ig] * aKK[r] * dec : 0.f;
            ATT[(size_t)unit * 4096 + ig * 64 + jg] = f2bf(aQK[r] * dec); }
    }
    LDS_BAR();
    for (int rp4 = 0; rp4 < (PROBE_SEL == 9 ? 2 : 1); ++rp4)
    { const float Gl = Gc[63];
#pragma unroll
        for (int e = 0; e < 2; ++e) { const int idx = tid + NTHR * e, r = idx >> 4, c8 = (idx & 15) * 8; const float sc = eG[r];
            const f32x4 a = *(const LAS f32x4*)(Xq + r * XS + c8) * sc, c = *(const LAS f32x4*)(Xq + r * XS + c8 + 4) * sc;
            *(u32x4*)(QG + ((size_t)unit * 64 + r) * 128 + c8) = pack8u(a, c); }
#pragma unroll
        for (int e = 0; e < 2; ++e) { const int idx = tid + NTHR * e, dk = idx & 127, t8 = (idx >> 7) * 8; f32x4 a, c;
#pragma unroll
            for (int j = 0; j < 4; ++j) { a[j] = Xk[(t8 + j) * XS + dk] * __expf(Gl - Gc[t8 + j]); c[j] = Xk[(t8 + 4 + j) * XS + dk] * __expf(Gl - Gc[t8 + 4 + j]); }
            *(u32x4*)(KDT + ((size_t)unit * 128 + dk) * 64 + t8) = pack8u(a, c); } }
    LDS_BAR();
#pragma unroll
    for (int e = 0; e < 4; ++e) { const int idx = tid + NTHR * e, r = idx >> 5, c4 = (idx & 31) * 4; const float bt = beta[r], bw = bt * eG[r];
        *(LAS f32x4*)(Xv + r * XS + c4) = *(const LAS f32x4*)(Xv + r * XS + c4) * bt;
        *(LAS f32x4*)(Xq + r * XS + c4) = *(const LAS f32x4*)(Xk + r * XS + c4) * bw; }
    LAS float* TI = (LAS float*)(lds + OFF_TI);
    if (tid < 64) { const int Ib = tid >> 4, j = tid & 15; const LAS float* Lb = Lm + (16 * Ib) * 64 + 16 * Ib;
        float tv[16];
#pragma unroll
        for (int r = 0; r < 16; ++r) { float sacc = (r == j) ? 1.0f : 0.0f;
#pragma unroll
            for (int c4 = 0; c4 < (r + 3) / 4; ++c4) { const f32x4 L4 = *(const LAS f32x4*)(Lb + r * 64 + 4 * c4);
#pragma unroll
                for (int e = 0; e < 4; ++e) if (4 * c4 + e < r) sacc -= L4[e] * tv[4 * c4 + e]; }
            tv[r] = sacc; TI[(Ib * 16 + r) * 16 + j] = sacc; } }
    LDS_BAR();
    { LAS float* Xb0 = ((wid * 2) < 8 ? Xv : Xq) + ((wid * 2) & 7) * 16; LAS float* Xb1 = ((wid * 2 + 1) < 8 ? Xv : Xq) + ((wid * 2 + 1) & 7) * 16;
      const int li = lane & 15, lq = lane >> 4;
#pragma unroll 1
      for (int I = 0; I < 4; ++I) {
          f32x4 a0 = {0.f, 0.f, 0.f, 0.f}, a1 = {0.f, 0.f, 0.f, 0.f};
          const LAS float* pa = Lm + (16 * I + li) * 64 + lq;
#pragma unroll 4
          for (int kk = 0; kk < 16 * I; kk += 4) { const float av = pa[kk];
              a0 = __builtin_amdgcn_mfma_f32_16x16x4f32(av, Xb0[(kk + lq) * XS + li], a0, 0, 0, 0);
              a1 = __builtin_amdgcn_mfma_f32_16x16x4f32(av, Xb1[(kk + lq) * XS + li], a1, 0, 0, 0); }
#pragma unroll
          for (int r = 0; r < 4; ++r) { LAS float* x0 = Xb0 + (16 * I + 4 * lq + r) * XS + li; LAS float* x1 = Xb1 + (16 * I + 4 * lq + r) * XS + li; *x0 -= a0[r]; *x1 -= a1[r]; }
          asm volatile("s_waitcnt lgkmcnt(0)" ::: "memory");
          f32x4 y0 = {0.f, 0.f, 0.f, 0.f}, y1 = {0.f, 0.f, 0.f, 0.f};
          const LAS float* pt = TI + (I * 16 + li) * 16 + lq;
#pragma unroll
          for (int sx = 0; sx < 4; ++sx) { const float tvv = pt[4 * sx];
              y0 = __builtin_amdgcn_mfma_f32_16x16x4f32(tvv, Xb0[(16 * I + 4 * sx + lq) * XS + li], y0, 0, 0, 0);
              y1 = __builtin_amdgcn_mfma_f32_16x16x4f32(tvv, Xb1[(16 * I + 4 * sx + lq) * XS + li], y1, 0, 0, 0); }
#pragma unroll
          for (int r = 0; r < 4; ++r) { Xb0[(16 * I + 4 * lq + r) * XS + li] = y0[r]; Xb1[(16 * I + 4 * lq + r) * XS + li] = y1[r]; }
          asm volatile("s_waitcnt lgkmcnt(0)" ::: "memory");
      } }
    LDS_BAR();
#pragma unroll
    for (int e = 0; e < 4; ++e) { const int idx = tid + NTHR * e, r = idx >> 5, c4 = (idx & 31) * 4;
        *(f32x4*)(U + ((size_t)unit * 64 + r) * 128 + c4) = *(const LAS f32x4*)(Xv + r * XS + c4);
        *(u32x2*)(Wg + ((size_t)unit * 64 + r) * 128 + c4) = pack4u(*(const LAS f32x4*)(Xq + r * XS + c4)); }
    LDS_BAR();
}

constexpr int SS = 136, VS = 72, OS = 132;
constexpr int OFF_ST = 0, OFF_VT = 128 * SS * 2, OFF_OT = OFF_VT + 128 * VS * 2, OFF_WQ = OFF_OT + 64 * OS * 4;
static_assert(OFF_WQ + 65536 <= MISC_OFF, "scan LDS");
__device__ __forceinline__ void scan_unit(LAS unsigned char* lds, const Params& p, int l, int bh) {
    int tid = threadIdx.x; asm volatile("" : "+v"(tid));
    const int wid = __builtin_amdgcn_readfirstlane(tid >> 6), lane = tid & 63, r32 = lane & 31, hi = lane >> 5;
    const int tm = wid & 1, tn = wid >> 1, b = bh / NH, h = bh % NH;
    LAS bf16_t* St = (LAS bf16_t*)(lds + OFF_ST); LAS bf16_t* Vt = (LAS bf16_t*)(lds + OFF_VT); LAS float* Ot = (LAS float*)(lds + OFF_OT);
    const float* U = (const float*)(p.ws + WS_H); const bf16_t* Wg = (const bf16_t*)(p.ws + AR_WG); const bf16_t* QG = (const bf16_t*)(p.ws + AR_QG);
    const bf16_t* KDT = (const bf16_t*)(p.ws + AR_KDT); const bf16_t* ATT = (const bf16_t*)(p.ws + AR_ATT); const float* EGL = (const float*)(p.ws + WS_EGL);
    const bf16_t* Z = (const bf16_t*)(p.ws + AR_Z); bf16_t* GO = (bf16_t*)(p.ws + AR_GO);
    f32x16 S0 = {}, S1 = {};
    for (int i = tid; i < 128 * SS / 2; i += NTHR) ((LAS unsigned*)St)[i] = 0u;
    LDS_BAR();
    const int gseg = tid & 7, gtok = tid >> 3;
    bf16x8 aa[4], ka[4], kb[4]; float uu[16]; u32x4 z0, z1;
    int dsrc[2];
#pragma unroll
    for (int i = 0; i < 2; ++i) { const int id = tid + i * NTHR, row = id >> 4, cc = id & 15; dsrc[i] = row * 128 + ((cc ^ (row & 7)) << 3); }
#define SCAN_DMA(cu_, bf_) do { const bf16_t* wsrc_ = Wg + (cu_) * 8192; const bf16_t* qsrc_ = QG + (cu_) * 8192; \
        _Pragma("unroll") for (int i = 0; i < 2; ++i) { \
            __builtin_amdgcn_global_load_lds((const unsigned*)(wsrc_ + dsrc[i]), (LAS unsigned*)(lds + OFF_WQ + (bf_) * 32768 + (i * NTHR + wid * 64) * 16), 16, 0, 0); \
            __builtin_amdgcn_global_load_lds((const unsigned*)(qsrc_ + dsrc[i]), (LAS unsigned*)(lds + OFF_WQ + (bf_) * 32768 + 16384 + (i * NTHR + wid * 64) * 16), 16, 0, 0); } } while (0)
#define SCAN_LD_U(cu_) do { const float* up = U + ((cu_) * 64 + 32 * tm) * 128 + 32 * tn + r32; _Pragma("unroll") for (int r = 0; r < 16; ++r) uu[r] = up[(size_t)crow(r, hi) * 128]; } while (0)
#define SCAN_LD_AA(cu_) do { const bf16_t* ap = ATT + ((cu_) * 64 + 32 * tm + r32) * 64 + 8 * hi; \
        _Pragma("unroll") for (int ks = 0; ks < 4; ++ks) aa[ks] = *(const bf16x8*)(ap + 16 * ks); } while (0)
#define SCAN_LD_K(cu_) do { const bf16_t* k0 = KDT + ((cu_) * 128 + 64 * tm + r32) * 64 + 8 * hi; \
        _Pragma("unroll") for (int ks = 0; ks < 4; ++ks) { ka[ks] = *(const bf16x8*)(k0 + 16 * ks); kb[ks] = *(const bf16x8*)(k0 + 32 * 64 + 16 * ks); } } while (0)
#define SCAN_LD_Z(n_) do { const size_t go_ = ((size_t)b * SEQ + (n_) * CHK + gtok) * 1024 + h * 128 + gseg * 16; z0 = *(const u32x4*)(Z + go_); z1 = *(const u32x4*)(Z + go_ + 8); } while (0)
    LAS float* Gn = (LAS float*)(lds + OFF_WQ + 65536);
    if (tid < 128) Gn[tid] = p.gdn_norm[l * 128 + tid];
    { const size_t cu0 = (size_t)bh * NCH; SCAN_DMA(cu0, 0); SCAN_DMA(cu0 + 1, 1); SCAN_LD_U(cu0); SCAN_LD_K(cu0); SCAN_LD_Z(0); }
    asm volatile("s_waitcnt vmcnt(0)" ::: "memory");
    LDS_BAR();
    const int arow = (32 * tm + r32) * 256;
    int abase[4];
#pragma unroll
    for (int dd = 0; dd < 4; ++dd) abase[dd] = arow + (((2 * dd + hi) ^ (r32 & 7)) << 4);
#pragma unroll 1
    for (int n = 0; n < NCH; ++n) {
        const size_t cu = (size_t)bh * NCH + n;
        const int n1 = (n + 1 < NCH) ? n + 1 : NCH - 1, n2 = (n + 2 < NCH) ? n + 2 : NCH - 1;
        const size_t cu1 = (size_t)bh * NCH + n1, cu2 = (size_t)bh * NCH + n2;
        const float egl = EGL[cu];
        SCAN_LD_AA(cu);
        f32x16 aW = {}, aQ = {};
        { const LAS bf16_t* sp = St + (32 * tn + r32) * SS + 8 * hi; const LAS unsigned char* wq = lds + OFF_WQ + (n & 1) * 32768;
#pragma unroll
          for (int ks = 0; ks < 8; ++ks) { const bf16x8 sb = *(const LAS bf16x8*)(sp + 16 * ks);
              const bf16x8 wa = *(const LAS bf16x8*)(wq + abase[ks & 3] + (ks >> 2) * 128), qa = *(const LAS bf16x8*)(wq + 16384 + abase[ks & 3] + (ks >> 2) * 128);
              aW = __builtin_amdgcn_mfma_f32_32x32x16_bf16(wa, sb, aW, 0, 0, 0); aQ = __builtin_amdgcn_mfma_f32_32x32x16_bf16(qa, sb, aQ, 0, 0, 0); } }
#pragma unroll
        for (int r4 = 0; r4 < 4; ++r4) { f32x4 vn;
#pragma unroll
            for (int j = 0; j < 4; ++j) { const int r = 4 * r4 + j; vn[j] = uu[r] - aW[r]; }
            *(LAS u32x2*)(Vt + (32 * tn + r32) * VS + 32 * tm + 8 * r4 + 4 * hi) = pack4u(vn); }
        SCAN_LD_U(cu1);
        LDS_BAR();
        if (n & 1) SCAN_DMA(cu2, 1); else SCAN_DMA(cu2, 0);
        { const LAS bf16_t* vp = Vt + (32 * tn + r32) * VS + 8 * hi;
          S0 *= egl; S1 *= egl;
#pragma unroll
          for (int ks = 0; ks < 4; ++ks) { const bf16x8 vb = *(const LAS bf16x8*)(vp + 16 * ks);
              aQ = __builtin_amdgcn_mfma_f32_32x32x16_bf16(aa[ks], vb, aQ, 0, 0, 0);
              S0 = __builtin_amdgcn_mfma_f32_32x32x16_bf16(ka[ks], vb, S0, 0, 0, 0); S1 = __builtin_amdgcn_mfma_f32_32x32x16_bf16(kb[ks], vb, S1, 0, 0, 0); } }
        SCAN_LD_K(cu1);
#pragma unroll
        for (int r = 0; r < 16; ++r) Ot[(32 * tm + crow(r, hi)) * OS + 32 * tn + r32] = aQ[r];
#pragma unroll
        for (int r4 = 0; r4 < 4; ++r4) { const f32x4 a = {S0[4 * r4], S0[4 * r4 + 1], S0[4 * r4 + 2], S0[4 * r4 + 3]}, c = {S1[4 * r4], S1[4 * r4 + 1], S1[4 * r4 + 2], S1[4 * r4 + 3]};
            LAS bf16_t* sp = St + (32 * tn + r32) * SS + 64 * tm + 8 * r4 + 4 * hi;
            *(LAS u32x2*)sp = pack4u(a); *(LAS u32x2*)(sp + 32) = pack4u(c); }
        asm volatile("s_waitcnt vmcnt(28)" ::: "memory");
        LDS_BAR();
        { const LAS float* op = Ot + gtok * OS + gseg * 16; f32x4 ov[4]; float s = 0.f;
#pragma unroll
          for (int j = 0; j < 4; ++j) { ov[j] = *(const LAS f32x4*)(op + 4 * j); s += (ov[j][0] * ov[j][0] + ov[j][1] * ov[j][1]) + (ov[j][2] * ov[j][2] + ov[j][3] * ov[j][3]); }
          s += swz<1>(s); s += swz<2>(s); s += swz<4>(s);
          const float rs = rsqrtf(s * (1.0f / 128.0f) + EPS);
          const size_t go = ((size_t)b * SEQ + n * CHK + gtok) * 1024 + h * 128 + gseg * 16;
          float zf[16];
#pragma unroll
          for (int j = 0; j < 4; ++j) { zf[2 * j] = bflo(z0[j]); zf[2 * j + 1] = bfhi(z0[j]); zf[8 + 2 * j] = bflo(z1[j]); zf[8 + 2 * j + 1] = bfhi(z1[j]); }
          SCAN_LD_Z(n1);
          f32x4 q[4];
#pragma unroll
          for (int j = 0; j < 4; ++j) { const f32x4 gnj = *(const LAS f32x4*)(Gn + gseg * 16 + 4 * j);
#pragma unroll
              for (int e = 0; e < 4; ++e) q[j][e] = ov[j][e] * rs * gnj[e] * siluf_(zf[4 * j + e]); }
          *(u32x4*)(GO + go) = pack8u(q[0], q[1]); *(u32x4*)(GO + go + 8) = pack8u(q[2], q[3]); }
    }
    asm volatile("s_waitcnt vmcnt(0)" ::: "memory");
#undef SCAN_DMA
#undef SCAN_LD_U
#undef SCAN_LD_AA
#undef SCAN_LD_K
#undef SCAN_LD_Z
    LDS_BAR();
}
}

#define XB_TMO      128
#define XB_XCNT(j)  (256  + 64 * (j))
#define XB_XSUB(j)  (1280 + 64 * (j))
#define XB_XGEN(j)  (2304 + 64 * (j))
#define XB_TOP      3328
#define XB_TOPGEN   3392
#define XCD_BAR_WORDS 3456
#define XB_SPIN_CAP (1u << 18)
__device__ __forceinline__ unsigned xb_ld(unsigned* p)              { return __hip_atomic_load(p, __ATOMIC_RELAXED, __HIP_MEMORY_SCOPE_AGENT); }
__device__ __forceinline__ unsigned xb_add(unsigned* p, unsigned v) { return __hip_atomic_fetch_add(p, v, __ATOMIC_RELAXED, __HIP_MEMORY_SCOPE_AGENT); }
__device__ __forceinline__ unsigned xb_xcc_id() { return (unsigned)__builtin_amdgcn_s_getreg((3 << 11) | 20) & 0xFu; }
#define XB_SPIN(cond, bar) do { unsigned _sp = 0; while (cond) { __builtin_amdgcn_s_sleep(1); \
    if ((++_sp & 255u) == 0u) { if (xb_ld(&(bar)[XB_TMO])) break; if (_sp > XB_SPIN_CAP) { atomicAdd(&(bar)[XB_TMO], 1u); break; } } } } while (0)
struct XcdBarrier { unsigned* bar; unsigned x; volatile LAS unsigned* st; };
__device__ __forceinline__ XcdBarrier xcd_barrier_post(unsigned* bar, volatile LAS unsigned* st) {
    XcdBarrier b; b.bar = bar; b.x = xb_xcc_id(); b.st = st;
    if (threadIdx.x == 0) (void)xb_add(&bar[XB_XCNT(b.x)], 1u);
    return b;
}
__device__ __forceinline__ void xcd_barrier_complete(unsigned* bar, unsigned x, unsigned& nloc, unsigned& nx) {
    const unsigned G = gridDim.x * gridDim.y * gridDim.z;
    unsigned sum, cnt, mine, sp = 0u;
    for (;;) {
        sum = 0u; cnt = 0u; mine = 0u;
#pragma unroll
        for (unsigned j = 0; j < 16; ++j) { const unsigned c = xb_ld(&bar[XB_XCNT(j)]); sum += c; cnt += (c > 0u) ? 1u : 0u; mine = (j == x) ? c : mine; }
        if (sum == G) break;
        __builtin_amdgcn_s_sleep(1);
        if ((++sp & 255u) == 0u) { if (xb_ld(&bar[XB_TMO])) break; if (sp > XB_SPIN_CAP) { atomicAdd(&bar[XB_TMO], 1u); break; } }
    }
    nloc = mine > 0u ? mine : 1u; nx = cnt > 0u ? cnt : 1u;
}
__device__ __forceinline__ void xcd_barrier(const XcdBarrier& b) {
    asm volatile("s_waitcnt vmcnt(0)" ::: "memory");
    __syncthreads();
    if (threadIdx.x == 0) {
        unsigned* bar = b.bar;
        __builtin_amdgcn_s_waitcnt(0);
        unsigned nloc = b.st[0], nx = b.st[1];
        if (nloc == 0u) { xcd_barrier_complete(bar, b.x, nloc, nx); b.st[0] = nloc; b.st[1] = nx; }
        const unsigned old = xb_add(&bar[XB_XSUB(b.x)], 1u);
        const unsigned gen = old / nloc;
        if (old + 1u == (gen + 1u) * nloc) {
            __builtin_amdgcn_fence(__ATOMIC_RELEASE, "agent");
            asm volatile("s_waitcnt vmcnt(0)" ::: "memory");
            const unsigned og = xb_add(&bar[XB_TOP], 1u);
            const unsigned tg = og / nx;
            if (og + 1u == (tg + 1u) * nx) xb_add(&bar[XB_TOPGEN], 1u);
            else XB_SPIN(xb_ld(&bar[XB_TOPGEN]) == tg, bar);
            __builtin_amdgcn_fence(__ATOMIC_ACQUIRE, "agent");
            xb_add(&bar[XB_XGEN(b.x)], 1u);
            asm volatile("s_waitcnt vmcnt(0)" ::: "memory");
        } else {
            XB_SPIN(xb_ld(&bar[XB_XGEN(b.x)]) == gen, bar);
            __builtin_amdgcn_fence(__ATOMIC_ACQUIRE, "agent");
            asm volatile("s_waitcnt vmcnt(0)" ::: "memory");
        }
    }
    __syncthreads();
}

#ifndef PH_MASK
#define PH_MASK 0xFFFFF
#endif
#define PHE(k) ((PH_MASK >> (k)) & 1)
constexpr int NPHASE = 20;
__device__ __forceinline__ WDesc wdesc(const Params& p, int l, int i) {
    WDesc w; w.ksc = nullptr;
    switch (i) {
    case 0: w.src = p.w_in + (size_t)l * D * INW; w.dst = (bf16_t*)(p.ws + WS_WIN); w.K = D; w.Nsrc = INW; w.Ndst = INWP; w.type = WT_IN; break;
    case 1: w.src = p.w_uq + (size_t)l * 512 * 1536; w.dst = (bf16_t*)(p.ws + WS_WUQ); w.K = 512; w.Nsrc = 1536; w.Ndst = 1536; w.type = WT_UQ; w.ksc = p.q_a_norm + l * 512; break;
    case 2: w.src = p.w_ukv + (size_t)l * 512 * 2048; w.dst = (bf16_t*)(p.ws + WS_WUKV); w.K = 512; w.Nsrc = 2048; w.Ndst = 2048; w.type = WT_NAT; w.ksc = p.kv_a_norm + l * 512; break;
    case 3: w.src = p.w_o_mla + (size_t)l * 1024 * 2048; w.dst = (bf16_t*)(p.ws + WS_WOM); w.K = 1024; w.Nsrc = 2048; w.Ndst = 2048; w.type = WT_NAT; break;
    case 4: w.src = p.w_o_gdn + (size_t)l * 1024 * 2048; w.dst = (bf16_t*)(p.ws + WS_WOG); w.K = 1024; w.Nsrc = 2048; w.Ndst = 2048; w.type = WT_NAT; break;
    case 5: w.src = p.w_o + (size_t)l * 2048 * 2048; w.dst = (bf16_t*)(p.ws + WS_WO); w.K = 2048; w.Nsrc = 2048; w.Ndst = 2048; w.type = WT_NAT; break;
    case 6: w.src = p.w_gate_up + (size_t)l * 2048 * 11264; w.dst = (bf16_t*)(p.ws + AR_WGU); w.K = 2048; w.Nsrc = 11264; w.Ndst = 11264; w.type = WT_GU; break;
    default: w.src = p.w_down + (size_t)l * DFF * 2048; w.dst = (bf16_t*)(p.ws + AR_WDN); w.K = DFF; w.Nsrc = 2048; w.Ndst = 2048; w.type = WT_NAT; break;
    }
    return w;
}
__device__ __forceinline__ void conv_weights(LAS unsigned char* lds, const Params& p, int l, int i0, int i1, int skip) {
    int total = 0;
    for (int i = i0; i < i1; ++i) { const WDesc w = wdesc(p, l, i); total += wtiles(w); }
    int first = (int)blockIdx.x - (skip % (int)gridDim.x); if (first < 0) first += gridDim.x;
    for (int it = first; it < total; it += gridDim.x) {
        int it2 = it;
        for (int i = i0; i < i1; ++i) { const WDesc w = wdesc(p, l, i); const int n = wtiles(w); if (it2 < n) { conv_item(lds, w, it2); break; } it2 -= n; }
    }
}

__global__ void __launch_bounds__(NTHR) mega(Params p) {
    extern __shared__ __attribute__((aligned(16))) unsigned char smem[];
    LAS unsigned char* lds = (LAS unsigned char*)smem;
    cg::grid_group grid = cg::this_grid();
    unsigned char* ws = p.ws;
    float* MOD = (float*)(ws + WS_MOD); bf16_t* XA = (bf16_t*)(ws + WS_XA); bf16_t* H = (bf16_t*)(ws + WS_H);
    unsigned* ctr = (unsigned*)(ws + WS_CTL);
    volatile LAS unsigned* bst = (volatile LAS unsigned*)(lds + MISC_OFF + 16);
    if (threadIdx.x == 0) { bst[0] = 0u; bst[1] = 0u; }
    __syncthreads();
    const XcdBarrier xbar = xcd_barrier_post((unsigned*)(ws + WS_BAR), bst);
    for (int ph = p.ph_lo; ph < p.ph_hi; ++ph) {
        if (ph == 0) { if (PHE(0)) { for (int rp = 0; rp < (PROBE_SEL == 3 ? 2 : 1); ++rp) {
            { int t0 = threadIdx.x; asm volatile("" : "+v"(t0)); if (blockIdx.x == 0 && t0 < 64) ctr[t0] = 0u; }
            for (int it = blockIdx.x; it < 192 + 128; it += gridDim.x) { if (it < 192) ada_item(lds, p, it); else rope_item(p, it - 192); }
            conv_weights(lds, p, 0, 0, 6, 320); } }
        } else if (ph == NPHASE - 1) {
            if (PHE(10)) norm_rows<true, true>(nullptr, XA, p.final_norm, nullptr, 0, 0, nullptr, p.out);
        } else {
            const int l = (ph - 1) / 9, s = (ph - 1) % 9;
            const float* modl = MOD + (size_t)l * NB * 6 * D;
            switch (s) {
            case 0: if (PHE(1)) { if (l > 0) conv_weights(lds, p, l, 0, 6, 0);
                if (l == 0) norm_rows<false, false>(p.x, nullptr, p.norm_mix + l * D, modl, 0, 1, H, nullptr);
                else norm_rows<false, true>(nullptr, XA, p.norm_mix + l * D, modl, 0, 1, H, nullptr); } break;
            case 1: if (PHE(2)) { EpiIn e; e.CQ = (bf16_t*)(ws + AR_CQ); e.CKV = (bf16_t*)(ws + AR_CKV); e.QKVG = (bf16_t*)(ws + AR_QKVG); e.Z = (bf16_t*)(ws + AR_Z); e.GATE = (bf16_t*)(ws + AR_GATE);
                e.Kb = (bf16_t*)(ws + AR_K); e.SSQ = (float*)(ws + WS_SSQ); e.BA = (float*)(ws + WS_BA); e.COS = (const float*)(ws + WS_COS); e.SIN = (const float*)(ws + WS_SIN);
                pg8::gemm_phase(lds, pg8::Gemm{H, (const bf16_t*)(ws + WS_WIN), T, INWP, D}, e); } break;
            case 2: if (PHE(3)) { EpiQKV e; e.Q = (bf16_t*)(ws + AR_Q); e.Kb = (bf16_t*)(ws + AR_K); e.Vb = (bf16_t*)(ws + AR_V); e.SSQ = (const float*)(ws + WS_SSQ); e.COS = (const float*)(ws + WS_COS); e.SIN = (const float*)(ws + WS_SIN);
#ifndef NO_UP
#pragma unroll 1
                for (int g = 0; g < 2; ++g) { e.mode = g;
                    pg8::gemm_phase(lds, pg8::Gemm{(const bf16_t*)(ws + (g ? AR_CKV : AR_CQ)), (const bf16_t*)(ws + (g ? WS_WUKV : WS_WUQ)), T, g ? 2048 : 1536, 512}, e); }
#endif
#ifndef NO_PREP
                for (int rp = 0; rp < (PROBE_SEL == 2 ? 2 : 1); ++rp)
                for (int u = blockIdx.x; u < NB * NH * NCH; u += gridDim.x) gdn::prep_unit(lds, p, l, u);
#endif
                } break;
            case 3: if (PHE(4)) { for (int rp = 0; rp < (PROBE_SEL == 1 ? 2 : 1); ++rp) {
#if DBG_NO_SCAN
                { int t0 = threadIdx.x; asm volatile("" : "+v"(t0)); u32x4 z4 = {0u,0u,0u,0u}; for (size_t i = (size_t)blockIdx.x * NTHR + t0; i < (size_t)T * 1024 / 8; i += (size_t)gridDim.x * NTHR) ((u32x4*)(ws + AR_GO))[i] = z4; }
#else
                if (blockIdx.x < NB * NH) gdn::scan_unit(lds, p, l, blockIdx.x);
                if (PROBE_SEL == 5 && blockIdx.x < NB * NH) gdn::scan_unit(lds, p, l, blockIdx.x);
#endif
#if DBG_NO_ATT
                { int t0 = threadIdx.x; asm volatile("" : "+v"(t0)); u32x4 z4 = {0u,0u,0u,0u}; for (size_t i = (size_t)blockIdx.x * NTHR + t0; i < (size_t)T * 1024 / 8; i += (size_t)gridDim.x * NTHR) ((u32x4*)(ws + AR_AO))[i] = z4; }
#else
                LAS int* misc = (LAS int*)(lds + MISC_OFF);
                for (;;) { if (threadIdx.x == 0) misc[0] = (int)atomicAdd(ctr + l + 2 * rp, 1u);
                    __syncthreads(); const int i = misc[0]; __syncthreads();
                    if (i >= 512) break;
                    att::attn_unit(lds, (const bf16_t*)(ws + AR_Q), (const bf16_t*)(ws + AR_K), (const bf16_t*)(ws + AR_V), (bf16_t*)(ws + AR_AO), (i & 63) >> 3, i & 7, 7 - (i >> 6)); }
#endif
                } } break;
            case 4: if (PHE(5)) { EpiOut e; e.GATE = (const bf16_t*)(ws + AR_GATE); e.TMP = (float*)(ws + AR_TMP); e.MIX = (bf16_t*)(ws + AR_MIX);
#pragma unroll 1
                for (int g = 0; g < 2; ++g) { e.SECOND = g;
                    pg8::gemm_phase(lds, pg8::Gemm{(const bf16_t*)(ws + (g ? AR_GO : AR_AO)), (const bf16_t*)(ws + (g ? WS_WOG : WS_WOM)), T, 2048, 1024}, e); } } break;
            case 5: if (PHE(6)) { EpiResid e; e.XINF = (l == 0) ? p.x : nullptr; e.XIN16 = XA; e.XOUT = XA; e.GT = modl + 2 * D;
                pg8::gemm_phase(lds, pg8::Gemm{(const bf16_t*)(ws + AR_MIX), (const bf16_t*)(ws + WS_WO), T, 2048, 2048}, e); } break;
            case 6: if (PHE(7)) { for (int rp = 0; rp < (PROBE_SEL == 3 ? 2 : 1); ++rp) { conv_weights(lds, p, l, 6, 8, 0);
                norm_rows<false, true>(nullptr, XA, p.norm_ffn + l * D, modl, 3, 4, H, nullptr); } } break;
            case 7: if (PHE(8)) { EpiSwiGLU e; e.ACT = (bf16_t*)(ws + AR_ACT);
                pg8::gemm_phase(lds, pg8::Gemm{H, (const bf16_t*)(ws + AR_WGU), T, 11264, 2048}, e); } break;
            default: if (PHE(9)) { EpiResid e; e.XINF = nullptr; e.XIN16 = XA; e.XOUT = XA; e.GT = modl + 5 * D;
                pg8::gemm_phase(lds, pg8::Gemm{(const bf16_t*)(ws + AR_ACT), (const bf16_t*)(ws + AR_WDN), T, 2048, DFF}, e); } break;
            }
        }
        if (ph + 1 < p.ph_hi) { if (p.ph_hi < 0) grid.sync(); else xcd_barrier(xbar); }
    }
}

#ifndef MK_MULTI
#define MK_MULTI 0
#endif

#ifndef MK_REPS
#define MK_REPS 1
#endif
extern "C" void kernel_launch(void* const* d_in, const int* in_sizes, int n_in, void* d_out, int out_size, void* d_ws, size_t ws_size, hipStream_t stream) {
    static int grid = 0;
    if (grid == 0) {
        int dev = 0, cus = 0, per_cu = 0;
        (void)hipGetDevice(&dev);
        (void)hipDeviceGetAttribute(&cus, hipDeviceAttributeMultiprocessorCount, dev);
        if (hipFuncSetAttribute((const void*)mega, hipFuncAttributeMaxDynamicSharedMemorySize, LDS_BYTES) != hipSuccess) fprintf(stderr, "kernel_launch: hipFuncSetAttribute failed\n");
        if (hipOccupancyMaxActiveBlocksPerMultiprocessor(&per_cu, (const void*)mega, NTHR, LDS_BYTES) != hipSuccess || per_cu < 1) { fprintf(stderr, "kernel_launch: occupancy query says %d\n", per_cu); per_cu = 1; }
        (void)hipGetLastError();
        grid = cus * 1;
        if (grid <= 0) grid = 256;
        fprintf(stderr, "kernel_launch: grid %d (cus %d, per_cu %d), ws %zu need %zu\n", grid, cus, per_cu, ws_size, (size_t)WS_END);
    }
    if (ws_size < WS_END || n_in != 22) { (void)hipMemsetAsync(d_out, 0xFF, (size_t)out_size * 4, stream); return; }
    Params p{};
    p.x = (const float*)d_in[0]; p.c = (const float*)d_in[1]; p.pos = (const int*)d_in[2]; p.w_ada = (const float*)d_in[3]; p.b_ada = (const float*)d_in[4];
    p.norm_mix = (const float*)d_in[5]; p.norm_ffn = (const float*)d_in[6]; p.w_in = (const float*)d_in[7]; p.q_a_norm = (const float*)d_in[8]; p.kv_a_norm = (const float*)d_in[9];
    p.w_uq = (const float*)d_in[10]; p.w_ukv = (const float*)d_in[11]; p.w_o_mla = (const float*)d_in[12]; p.conv_w = (const float*)d_in[13]; p.A_log = (const float*)d_in[14];
    p.dt_bias = (const float*)d_in[15]; p.gdn_norm = (const float*)d_in[16]; p.w_o_gdn = (const float*)d_in[17]; p.w_o = (const float*)d_in[18]; p.w_gate_up = (const float*)d_in[19];
    p.w_down = (const float*)d_in[20]; p.final_norm = (const float*)d_in[21];
    p.out = (float*)d_out; p.ws = (unsigned char*)d_ws;
    (void)hipMemsetAsync((unsigned char*)d_ws + WS_BAR, 0, XCD_BAR_WORDS * 4, stream);
#if MK_MULTI
    for (int rep = 0; rep < MK_REPS; ++rep)
    for (int ph = 0; ph < NPHASE; ++ph) { p.ph_lo = ph; p.ph_hi = ph + 1; void* args[] = {&p};
        hipError_t e = hipLaunchCooperativeKernel((const void*)mega, dim3(grid), dim3(NTHR), args, LDS_BYTES, stream);
        if (e != hipSuccess) { fprintf(stderr, "cooperative launch failed: %s\n", hipGetErrorString(e)); break; } }
#else
    p.ph_lo = 0; p.ph_hi = NPHASE; void* args[] = {&p};
    hipError_t e = hipLaunchCooperativeKernel((const void*)mega, dim3(grid), dim3(NTHR), args, LDS_BYTES, stream);
    if (e != hipSuccess) fprintf(stderr, "cooperative launch failed: %s (grid %d)\n", hipGetErrorString(e), grid);
#endif
}
```
